# Optimizing an MI355X kernel written in HIP

```python
import math
import jax, jax.numpy as jnp
from jax import lax
import numpy as np

D_MODEL = 1024
BATCH = 8
SEQ = 2048
DEPTH = 1

SSM_EXPAND = 2
SSM_D_INNER = SSM_EXPAND * D_MODEL
SSM_HEAD_DIM = 64
SSM_N_HEADS = SSM_D_INNER // SSM_HEAD_DIM
SSM_N_GROUPS = 4
SSM_HEADS_PER_GROUP = SSM_N_HEADS // SSM_N_GROUPS
SSM_D_STATE = 128
SSM_CONV = 4
SSM_CHUNK = 128
SSM_CONV_DIM = SSM_D_INNER + 2 * SSM_N_GROUPS * SSM_D_STATE

ATT_HEAD_DIM = 64
ATT_N_HEADS = D_MODEL // (2 * ATT_HEAD_DIM)
ATT_V_DIM = 2 * ATT_HEAD_DIM
ATT_Q_BLOCK = 128
ROPE_THETA = 500000.0
ROPE_DIM = ATT_HEAD_DIM // 4

FFN_HIDDEN = ((8 * D_MODEL + 3 * 256 - 1) // (3 * 256)) * 256

RMS_EPS = 1e-6

Z_END = SSM_D_INNER
XBC_END = Z_END + SSM_CONV_DIM
DT_END = XBC_END + SSM_N_HEADS
Q_END = DT_END + 2 * ATT_N_HEADS * ATT_HEAD_DIM
K_END = Q_END + 2 * ATT_N_HEADS * ATT_HEAD_DIM
V_END = K_END + ATT_N_HEADS * ATT_V_DIM
IN_COLS = V_END + 2 * D_MODEL

kernel_name = "hybrid_ssd_diffattn_gated_block"


def rmsnorm(x, w):
    xf = x.astype(jnp.float32)
    y = xf * lax.rsqrt(jnp.mean(xf * xf, axis=-1, keepdims=True) + RMS_EPS)
    return (y * w.astype(jnp.float32)).astype(x.dtype)


def rope_partial(x, positions):
    half = ROPE_DIM // 2
    inv_freq = ROPE_THETA ** (-jnp.arange(0, ROPE_DIM, 2, dtype=jnp.float32) / ROPE_DIM)
    ang = positions.astype(jnp.float32)[..., None] * inv_freq
    cos = jnp.cos(ang)[:, :, None, :]
    sin = jnp.sin(ang)[:, :, None, :]
    x1 = x[..., :half].astype(jnp.float32)
    x2 = x[..., half:ROPE_DIM].astype(jnp.float32)
    rot = jnp.concatenate([x1 * cos - x2 * sin, x2 * cos + x1 * sin], axis=-1)
    return jnp.concatenate([rot.astype(x.dtype), x[..., ROPE_DIM:]], axis=-1)


def causal_depthwise_conv(u, w, b):
    out = lax.conv_general_dilated(
        u, w[:, None, :].astype(u.dtype), window_strides=(1,), padding=[(SSM_CONV - 1, 0)],
        dimension_numbers=("NWC", "WIO", "NWC"), feature_group_count=u.shape[-1])
    return out + b


def ssd_chunked(xh, dt, A, Bm, Cm):
    b, S = xh.shape[0], xh.shape[1]
    nc = S // SSM_CHUNK
    G, R, P, N = SSM_N_GROUPS, SSM_HEADS_PER_GROUP, SSM_HEAD_DIM, SSM_D_STATE
    xdt = (xh * dt[..., None]).reshape(b, nc, SSM_CHUNK, G, R, P)
    dA = (dt * A).reshape(b, nc, SSM_CHUNK, G, R)
    Bc = Bm.reshape(b, nc, SSM_CHUNK, G, N)
    Cc = Cm.reshape(b, nc, SSM_CHUNK, G, N)
    a_cs = jnp.cumsum(dA, axis=2)
    causal = jnp.tril(jnp.ones((SSM_CHUNK, SSM_CHUNK), dtype=bool))
    seg = a_cs[:, :, :, None] - a_cs[:, :, None, :]
    decay = jnp.exp(jnp.where(causal[None, None, :, :, None, None], seg, -jnp.inf))
    cb = jnp.einsum("bclgn,bcsgn->bclsg", Cc, Bc)
    y_diag = jnp.einsum("bclsg,bclsgr,bcsgrp->bclgrp", cb, decay, xdt)
    decay_to_end = jnp.exp(a_cs[:, :, -1:] - a_cs)
    chunk_states = jnp.einsum("bclgn,bclgr,bclgrp->bcgrpn", Bc, decay_to_end, xdt)
    chunk_decay = jnp.exp(a_cs[:, :, -1])

    def step(h, inp):
        st, dec = inp
        return h * dec[..., None, None] + st, h

    h0 = jnp.zeros((b, G, R, P, N), dtype=chunk_states.dtype)
    _, h_in = lax.scan(step, h0, (jnp.moveaxis(chunk_states, 1, 0), jnp.moveaxis(chunk_decay, 1, 0)))
    h_in = jnp.moveaxis(h_in, 0, 1)
    y_off = jnp.einsum("bclgn,bcgrpn,bclgr->bclgrp", Cc, h_in, jnp.exp(a_cs))
    return (y_diag + y_off).reshape(b, S, SSM_N_HEADS, P)


def mamba2_mixer(z, xbc, dt_raw, conv_w, conv_b, dt_bias, a_log, d_skip, norm_w):
    b, S, _ = z.shape
    xbc = jax.nn.silu(causal_depthwise_conv(xbc, conv_w, conv_b))
    xs, Bm, Cm = jnp.split(xbc, [SSM_D_INNER, SSM_D_INNER + SSM_N_GROUPS * SSM_D_STATE], axis=-1)
    xh = xs.reshape(b, S, SSM_N_HEADS, SSM_HEAD_DIM)
    Bm = Bm.reshape(b, S, SSM_N_GROUPS, SSM_D_STATE)
    Cm = Cm.reshape(b, S, SSM_N_GROUPS, SSM_D_STATE)
    dt = jax.nn.softplus((dt_raw + dt_bias).astype(jnp.float32))
    A = -jnp.exp(a_log.astype(jnp.float32))
    y = ssd_chunked(xh, dt, A, Bm, Cm) + xh * d_skip[:, None]
    y = y.reshape(b, S, SSM_D_INNER) * jax.nn.silu(z)
    g = y.reshape(b, S, SSM_N_GROUPS, SSM_D_INNER // SSM_N_GROUPS).astype(jnp.float32)
    g = g * lax.rsqrt(jnp.mean(g * g, axis=-1, keepdims=True) + RMS_EPS)
    return (g.reshape(b, S, SSM_D_INNER) * norm_w.astype(jnp.float32)).astype(z.dtype)


def diff_attention(q, k, v, positions, lam_q1, lam_k1, lam_q2, lam_k2, subln_w, lam_init):
    b, S, _ = q.shape
    H, d = ATT_N_HEADS, ATT_HEAD_DIM
    q = rope_partial(q.reshape(b, S, 2 * H, d), positions).reshape(b, S, H, 2, d)
    k = rope_partial(k.reshape(b, S, 2 * H, d), positions).reshape(b, S, H, 2, d)
    v = v.reshape(b, S, H, ATT_V_DIM)
    lam = (jnp.exp(jnp.sum(lam_q1.astype(jnp.float32) * lam_k1.astype(jnp.float32)))
           - jnp.exp(jnp.sum(lam_q2.astype(jnp.float32) * lam_k2.astype(jnp.float32))) + lam_init)
    nb = S // ATT_Q_BLOCK
    qb = (q * (d ** -0.5)).reshape(b, nb, ATT_Q_BLOCK, H, 2, d).transpose(1, 0, 2, 3, 4, 5)
    key_pos = jnp.arange(S)

    def block(args):
        qi, i = args
        s = jnp.einsum("bqhmd,bkhmd->bhmqk", qi, k).astype(jnp.float32)
        q_pos = i * ATT_Q_BLOCK + jnp.arange(ATT_Q_BLOCK)
        mask = key_pos[None, :] <= q_pos[:, None]
        p = jax.nn.softmax(jnp.where(mask, s, -jnp.inf), axis=-1)
        w = p[:, :, 0] - lam * p[:, :, 1]
        return jnp.einsum("bhqk,bkhe->bqhe", w.astype(v.dtype), v)

    o = lax.map(block, (qb, jnp.arange(nb)))
    o = o.transpose(1, 0, 2, 3, 4).reshape(b, S, H, ATT_V_DIM)
    o = rmsnorm(o, subln_w) * (1.0 - lam_init)
    return o.reshape(b, S, H * ATT_V_DIM)


def setup_inputs(seed: int = 0) -> dict:
    key = jax.random.key(seed)
    ks = jax.random.split(key, 24)
    f32 = jnp.float32

    def nrm(k, shape, scale):
        return jax.random.normal(k, shape, f32) * scale

    def gain(k, n):
        return 1.0 + 0.02 * jax.random.normal(k, (DEPTH, n), f32)

    x = jax.random.normal(ks[0], (BATCH, SEQ, D_MODEL), f32)
    offsets = jax.random.randint(ks[1], (BATCH, 1), 0, 4096, dtype=jnp.int32)
    positions = jnp.arange(SEQ, dtype=jnp.int32)[None, :] + offsets
    u = jax.random.uniform(ks[5], (DEPTH, SSM_N_HEADS), f32)
    dt0 = jnp.exp(u * (math.log(0.1) - math.log(0.001)) + math.log(0.001))
    dt_bias = dt0 + jnp.log(-jnp.expm1(-dt0))
    a_log = jnp.log(jax.random.uniform(ks[6], (DEPTH, SSM_N_HEADS), f32, 1.0, 16.0))
    return {
        "x": x,
        "positions": positions,
        "w_in": nrm(ks[2], (DEPTH, D_MODEL, IN_COLS), D_MODEL ** -0.5),
        "conv_w": nrm(ks[3], (DEPTH, SSM_CONV, SSM_CONV_DIM), SSM_CONV ** -0.5),
        "conv_b": nrm(ks[4], (DEPTH, SSM_CONV_DIM), 0.02),
        "dt_bias": dt_bias,
        "a_log": a_log,
        "d_skip": 1.0 + 0.02 * jax.random.normal(ks[7], (DEPTH, SSM_N_HEADS), f32),
        "ssm_norm_w": gain(ks[8], SSM_D_INNER),
        "w_ssm_out": nrm(ks[9], (DEPTH, SSM_D_INNER, D_MODEL), SSM_D_INNER ** -0.5),
        "lam_q1": nrm(ks[10], (DEPTH, ATT_HEAD_DIM), 0.1),
        "lam_k1": nrm(ks[11], (DEPTH, ATT_HEAD_DIM), 0.1),
        "lam_q2": nrm(ks[12], (DEPTH, ATT_HEAD_DIM), 0.1),
        "lam_k2": nrm(ks[13], (DEPTH, ATT_HEAD_DIM), 0.1),
        "attn_subln_w": gain(ks[14], ATT_V_DIM),
        "w_attn_out": nrm(ks[15], (DEPTH, ATT_N_HEADS * ATT_V_DIM, D_MODEL), (ATT_N_HEADS * ATT_V_DIM) ** -0.5),
        "w_mix_out": nrm(ks[16], (DEPTH, D_MODEL, D_MODEL), D_MODEL ** -0.5),
        "norm_pre_mix": gain(ks[17], D_MODEL),
        "norm_post_mix": gain(ks[18], D_MODEL),
        "norm_pre_ffn": gain(ks[19], D_MODEL),
        "norm_post_ffn": gain(ks[20], D_MODEL),
        "w_ffn_gate": nrm(ks[21], (DEPTH, D_MODEL, FFN_HIDDEN), D_MODEL ** -0.5),
        "w_ffn_up": nrm(ks[22], (DEPTH, D_MODEL, FFN_HIDDEN), D_MODEL ** -0.5),
        "w_ffn_down": nrm(ks[23], (DEPTH, FFN_HIDDEN, D_MODEL), FFN_HIDDEN ** -0.5),
    }


def reference(x, positions, w_in, conv_w, conv_b, dt_bias, a_log, d_skip, ssm_norm_w, w_ssm_out,
              lam_q1, lam_k1, lam_q2, lam_k2, attn_subln_w, w_attn_out, w_mix_out,
              norm_pre_mix, norm_post_mix, norm_pre_ffn, norm_post_ffn,
              w_ffn_gate, w_ffn_up, w_ffn_down):
    for l in range(DEPTH):
        lam_init = 0.8 - 0.6 * math.exp(-0.3 * l)
        h = rmsnorm(x, norm_pre_mix[l])
        proj = h @ w_in[l]
        z, xbc, dt_raw, q, k, v, gate_logits = jnp.split(
            proj, [Z_END, XBC_END, DT_END, Q_END, K_END, V_END], axis=-1)
        y_ssm = mamba2_mixer(z, xbc, dt_raw, conv_w[l], conv_b[l], dt_bias[l], a_log[l],
                             d_skip[l], ssm_norm_w[l]) @ w_ssm_out[l]
        y_att = diff_attention(q, k, v, positions, lam_q1[l], lam_k1[l], lam_q2[l], lam_k2[l],
                               attn_subln_w[l], lam_init) @ w_attn_out[l]
        gates = jax.nn.sigmoid(gate_logits.astype(jnp.float32)).astype(x.dtype)
        g_ssm, g_att = jnp.split(gates, 2, axis=-1)
        mixed = (g_ssm * y_ssm + g_att * y_att) @ w_mix_out[l]
        x = x + rmsnorm(mixed, norm_post_mix[l])
        h = rmsnorm(x, norm_pre_ffn[l])
        f = (jax.nn.silu(h @ w_ffn_gate[l]) * (h @ w_ffn_up[l])) @ w_ffn_down[l]
        x = x + rmsnorm(f, norm_post_ffn[l])
    return x
```

```cpp
#include <hip/hip_runtime.h>
#include <hip/hip_cooperative_groups.h>
#include <cstdio>
#include <cstdint>
namespace cg = cooperative_groups;

#define LAS __attribute__((address_space(3)))
typedef unsigned short bf16_t;
typedef short bf16x8 __attribute__((ext_vector_type(8)));
typedef short s16x4 __attribute__((ext_vector_type(4)));
typedef float f32x4 __attribute__((ext_vector_type(4)));
typedef float f32x16 __attribute__((ext_vector_type(16)));
typedef unsigned u32x4 __attribute__((ext_vector_type(4)));
typedef unsigned u32x2 __attribute__((ext_vector_type(2)));
typedef float f32x2_t __attribute__((ext_vector_type(2)));
typedef __bf16 bf16x2_t __attribute__((ext_vector_type(2)));
#define DI __device__ __forceinline__

DI int otid() { int t = threadIdx.x; asm volatile("" : "+v"(t)); return t; }
DI unsigned cvtpk(float lo, float hi) { f32x2_t v = {lo, hi}; bf16x2_t b = __builtin_convertvector(v, bf16x2_t); return __builtin_bit_cast(unsigned, b); }
DI float bflo(unsigned w) { return __uint_as_float(w << 16); }
DI float bfhi(unsigned w) { return __uint_as_float(w & 0xffff0000u); }
DI float silu_f(float x) { return x / (1.f + __expf(-x)); }
DI float sigmoid_f(float x) { return 1.f / (1.f + __expf(-x)); }

constexpr int T_TOK = 16384, SEQ = 2048, DM = 1024, NB = 8;
constexpr int NHS = 32, DIN = 2048, XBCW = 3072, FFH = 2816;
constexpr int N1A = 5376, N1B = 5120, NIN = N1A + N1B;
constexpr float EPS = 1e-6f;
constexpr float QSCALE = 0.125f * 1.4426950408889634f;
constexpr float LAM_INIT = 0.2f;

constexpr size_t MiB = 1u << 20;
constexpr size_t WS_ZY = 0, WS_R96 = 64 * MiB, WS_XN = 160 * MiB, WS_WIN = 192 * MiB, WS_WSSM = 213 * MiB, WS_WATT = 217 * MiB, WS_WMIX = 219 * MiB,
                 WS_WGU = 221 * MiB, WS_WDN = 232 * MiB, WS_DT = 238 * MiB, WS_ROPE = 240 * MiB, WS_END = 241 * MiB;
constexpr int LDS_BYTES = 147456;

struct Params {
    const float* x; const int* pos; const float* w_in; const float* conv_w; const float* conv_b; const float* dt_bias; const float* a_log; const float* d_skip;
    const float* ssm_norm_w; const float* w_ssm_out; const float* lq1; const float* lk1; const float* lq2; const float* lk2; const float* subln_w; const float* w_attn_out;
    const float* w_mix; const float* n_pre_mix; const float* n_post_mix; const float* n_pre_ffn; const float* n_post_ffn; const float* w_gate; const float* w_up; const float* w_down;
    float* out; unsigned char* ws;
};

namespace pg8 {
#define PG8_LAS __attribute__((address_space(3)))
constexpr int BM = 256, BK = 64, HALF = 128, HTB = HALF * BK * 2, STAGE_BYTES = 8 * HTB, NXCD = 8, WGM = 8;
__host__ __device__ __forceinline__ int lds_byte(int r, int c) { const int st = (r >> 4) * 2 + (c >> 5), rr = r & 15, cc = c & 31, ob = rr * 64 + cc * 2; return st * 1024 + (ob ^ (((ob >> 9) & 1) << 5)); }
__host__ __device__ __forceinline__ void stage_rc(int b, int& R, int& C) { const int st = b / 1024, sb = b % 1024, swz = sb ^ (((sb >> 9) & 1) << 5); R = (st >> 1) * 16 + swz / 64; C = (st & 1) * 32 + (swz % 64) / 2; }
__host__ __device__ __forceinline__ int perm32(int rho) { const int n = rho >> 4, i = rho & 15; return 8 * (i >> 2) + 4 * n + (i & 3); }
struct Unit { int pm, pn; };
struct Gemm { const bf16_t* A; const bf16_t* Bt; int M, N, K, lda; };
struct StaticOrder {
    int nM, nN, nwg, G, c;
    __host__ __device__ void init(int M, int N, int G_, int c_) { nM = M / BM; nN = N / BM; nwg = nM * nN; G = G_; c = c_; }
    __host__ __device__ bool next(int i, Unit& u) const {
        const long L = (long)i * G + c; if (L >= nwg) return false;
        int wgid = (int)L; { const int q = nwg / NXCD, r = nwg % NXCD, xcd = wgid % NXCD, off = wgid / NXCD; wgid = (xcd < r ? xcd * (q + 1) : r * (q + 1) + (xcd - r) * q) + off; }
        const int nig = WGM * nN, gid = wgid / nig, fm = gid * WGM, gsz = (nM - fm) < WGM ? (nM - fm) : WGM;
        u.pm = fm + ((wgid % nig) % gsz); u.pn = (wgid % nig) / gsz; return true;
    }
};
template <class Epi, class Sched, bool ALIGN_EPI, bool SP2>
__device__ __forceinline__ void gemm_phase(PG8_LAS unsigned char* lds, const Gemm g, const Sched& S, const Epi& E) {
    const int tid = otid(), wid = __builtin_amdgcn_readfirstlane(tid >> 6), lane = tid & 63, wr = wid >> 2, wc = wid & 3, fr = lane & 15, fq = lane >> 4;
    const int K = g.K, nt = K / BK, lda = g.lda;
    unsigned voffA[2], voffB[2];
#pragma unroll
    for (int i = 0; i < 2; ++i) { int R, C; stage_rc(tid * 16 + i * 8192, R, C); const int Rb = Epi::PERM ? ((R & ~31) + perm32(R & 31)) : R;
        voffA[i] = (unsigned)(R * lda + C) * 2u; voffB[i] = (unsigned)(Rb * K + C) * 2u; }
    const size_t kstep = (size_t)(BK * 2);
    const size_t hstepA = (size_t)HALF * lda * 2, hstepB = (size_t)HALF * K * 2;
    const size_t tstepA = 2 * hstepA, tstepB = 2 * hstepB;
    const unsigned ldsw = (unsigned)wid * 1024u;
    const int aoff = lds_byte(wr * 64 + fr, fq * 8), boff = lds_byte(wc * 32 + fr, fq * 8);
#define PG8_SA(b, h) (((b) * 2 + (h)) * HTB)
#define PG8_SB(b, h) ((4 + (b) * 2 + (h)) * HTB)
#define PG8_STAGE(bufoff, gbase, voff) do { _Pragma("unroll") for (int _i = 0; _i < 2; ++_i) \
        __builtin_amdgcn_global_load_lds((const unsigned*)((const char*)(gbase) + (voff)[_i]), (PG8_LAS unsigned*)(lds + (bufoff) + ldsw + _i * 8192), 16, 0, 0); } while (0)
#define PG8_LDA(dst, b, h) do { _Pragma("unroll") for (int m = 0; m < 4; ++m) _Pragma("unroll") for (int k = 0; k < 2; ++k) dst[m][k] = *(const PG8_LAS bf16x8*)(lds + PG8_SA(b, h) + aoff + m * 2048 + k * 1024); } while (0)
#define PG8_LDB(dst, b, h) do { _Pragma("unroll") for (int n = 0; n < 2; ++n) _Pragma("unroll") for (int k = 0; k < 2; ++k) dst[n][k] = *(const PG8_LAS bf16x8*)(lds + PG8_SB(b, h) + boff + n * 2048 + k * 1024); } while (0)
#define PG8_MMA(ai, bj, At, Bt) do { __builtin_amdgcn_s_setprio(1); _Pragma("unroll") for (int m = 0; m < 4; ++m) _Pragma("unroll") for (int n = 0; n < 2; ++n) _Pragma("unroll") for (int k = 0; k < 2; ++k) \
        acc[ai][bj][m][n] = __builtin_amdgcn_mfma_f32_16x16x32_bf16(Bt[n][k], At[m][k], acc[ai][bj][m][n], 0, 0, 0); __builtin_amdgcn_s_setprio(0); } while (0)
#define PG8_WAIT_V(n) asm volatile("s_waitcnt vmcnt(" #n ")" ::: "memory")
#define PG8_WAIT_L(n) asm volatile("s_waitcnt lgkmcnt(" #n ")" ::: "memory")
#define PG8_BAR __builtin_amdgcn_s_barrier()
#define PG8_SCHED __builtin_amdgcn_sched_barrier(0)
    Unit cur, nxt; int ui = 0;
    if (!S.next(0, cur)) return;
    f32x4 acc[2][2][4][2];
#pragma unroll
    for (int a = 0; a < 2; ++a)
#pragma unroll
        for (int b = 0; b < 2; ++b)
#pragma unroll
            for (int m = 0; m < 4; ++m)
#pragma unroll
                for (int n = 0; n < 2; ++n) acc[a][b][m][n] = (f32x4){0.f, 0.f, 0.f, 0.f};
    bf16x8 At[4][2], B0[2][2], B1[2][2];
    const char* cA = (const char*)g.A + (size_t)cur.pm * tstepA; const char* cB = (const char*)g.Bt + (size_t)cur.pn * tstepB;
    if constexpr (SP2) {
        PG8_STAGE(PG8_SB(0, 0), cB, voffB); PG8_STAGE(PG8_SB(0, 1), cB + hstepB, voffB); PG8_STAGE(PG8_SA(0, 0), cA, voffA); PG8_STAGE(PG8_SA(0, 1), cA + hstepA, voffA);
        if (wr == 1) PG8_BAR;
        PG8_WAIT_V(2); PG8_BAR;
        PG8_STAGE(PG8_SB(1, 0), cB + kstep, voffB); PG8_STAGE(PG8_SA(1, 0), cA + kstep, voffA); PG8_STAGE(PG8_SB(1, 1), cB + hstepB + kstep, voffB);
        PG8_WAIT_V(6); PG8_BAR;
    }
    for (;;) {
        const bool has_next = S.next(ui + 1, nxt);
        const char* nA = has_next ? (const char*)g.A + (size_t)nxt.pm * tstepA : cA; const char* nB = has_next ? (const char*)g.Bt + (size_t)nxt.pn * tstepB : cB;
        for (int t = 0; t < nt; t += 2) {
            const bool last = (t == nt - 2);
            const char* a1 = cA + (size_t)(t + 1) * kstep;
            const char* a2 = last ? nA : cA + (size_t)(t + 2) * kstep; const char* b2 = last ? nB : cB + (size_t)(t + 2) * kstep;
            const char* a3 = a2 + kstep; const char* b3 = b2 + kstep;
            PG8_LDB(B0, 0, 0); PG8_LDB(B1, 0, 1); PG8_SCHED; PG8_LDA(At, 0, 0); PG8_STAGE(PG8_SA(1, 1), a1 + hstepA, voffA);
            PG8_WAIT_V(8); PG8_WAIT_L(0); PG8_BAR; PG8_MMA(0, 0, At, B0); PG8_MMA(0, 1, At, B1); PG8_BAR; PG8_SCHED;
            PG8_LDA(At, 0, 1); PG8_STAGE(PG8_SB(0, 0), b2, voffB); PG8_STAGE(PG8_SB(0, 1), b2 + hstepB, voffB); PG8_STAGE(PG8_SA(0, 0), a2, voffA);
            PG8_WAIT_V(8); PG8_WAIT_L(0); PG8_BAR; PG8_MMA(1, 0, At, B0); PG8_MMA(1, 1, At, B1); PG8_BAR; PG8_SCHED;
            PG8_LDB(B0, 1, 0); PG8_LDB(B1, 1, 1); PG8_SCHED; PG8_LDA(At, 1, 0); PG8_STAGE(PG8_SA(0, 1), a2 + hstepA, voffA);
            PG8_WAIT_V(8); PG8_WAIT_L(0); PG8_BAR; PG8_MMA(0, 0, At, B0); PG8_MMA(0, 1, At, B1); PG8_BAR; PG8_SCHED;
            PG8_LDA(At, 1, 1); PG8_STAGE(PG8_SB(1, 0), b3, voffB); PG8_STAGE(PG8_SB(1, 1), b3 + hstepB, voffB); PG8_STAGE(PG8_SA(1, 0), a3, voffA);
            PG8_WAIT_V(8); PG8_WAIT_L(0); PG8_BAR; PG8_MMA(1, 0, At, B0); PG8_MMA(1, 1, At, B1); PG8_BAR; PG8_SCHED;
        }
        if constexpr (ALIGN_EPI) { if (wr == 0) PG8_BAR; }
        E(acc, cur, wr, wc, fr, fq);
        if (!has_next) break;
#pragma unroll
        for (int a = 0; a < 2; ++a)
#pragma unroll
            for (int b = 0; b < 2; ++b)
#pragma unroll
                for (int m = 0; m < 4; ++m)
#pragma unroll
                    for (int n = 0; n < 2; ++n) acc[a][b][m][n] = (f32x4){0.f, 0.f, 0.f, 0.f};
        cur = nxt; cA = nA; cB = nB; ++ui;
        if constexpr (ALIGN_EPI) { if (wr == 1) PG8_BAR; }
    }
    PG8_WAIT_V(0);
    if constexpr (!ALIGN_EPI) { if (wr == 0) PG8_BAR; }
    PG8_BAR;
#undef PG8_SA
#undef PG8_SB
#undef PG8_STAGE
#undef PG8_LDA
#undef PG8_LDB
#undef PG8_MMA
#undef PG8_WAIT_V
#undef PG8_WAIT_L
#undef PG8_BAR
#undef PG8_SCHED
}
}
using pg8::Unit;
typedef const f32x4 (&AccRef)[2][2][4][2];

DI void st8(bf16_t* p, f32x4 v0, f32x4 v1) { u32x4 w; w.x = cvtpk(v0[0], v0[1]); w.y = cvtpk(v0[2], v0[3]); w.z = cvtpk(v1[0], v1[1]); w.w = cvtpk(v1[2], v1[3]); *(u32x4*)p = w; }

struct EpiP1a {
    static constexpr bool PERM = true;
    bf16_t* ZY; bf16_t* XBC; float* DT; const float* dt_bias;
    DI void operator()(AccRef acc, const Unit& u, int wr, int wc, int fr, int fq) const {
        const int row0 = u.pm * 256 + wr * 64 + fr;
        if (u.pn < 20) {
            const bool isz = u.pn < 8;
            bf16_t* base = isz ? ZY : XBC; const int ld = isz ? DIN : XBCW; const int col0 = (isz ? u.pn : u.pn - 8) * 256 + wc * 32 + 8 * fq;
#pragma unroll
            for (int ai = 0; ai < 2; ++ai)
#pragma unroll
                for (int m = 0; m < 4; ++m) { bf16_t* rowp = base + (size_t)(row0 + ai * 128 + m * 16) * ld + col0;
#pragma unroll
                    for (int bj = 0; bj < 2; ++bj) { f32x4 v0 = acc[ai][bj][m][0], v1 = acc[ai][bj][m][1];
                        if (isz) {
#pragma unroll
                            for (int j = 0; j < 4; ++j) { v0[j] = silu_f(v0[j]); v1[j] = silu_f(v1[j]); } }
                        st8(rowp + bj * 128, v0, v1); } }
        } else if (wc == 0) {
            const int c0 = 8 * fq;
            const f32x4 b0 = *(const f32x4*)(dt_bias + c0), b1 = *(const f32x4*)(dt_bias + c0 + 4);
#pragma unroll
            for (int ai = 0; ai < 2; ++ai)
#pragma unroll
                for (int m = 0; m < 4; ++m) { float* rowp = DT + (size_t)(row0 + ai * 128 + m * 16) * NHS + c0;
                    f32x4 v0 = acc[ai][0][m][0] + b0, v1 = acc[ai][0][m][1] + b1;
#pragma unroll
                    for (int j = 0; j < 4; ++j) { v0[j] = v0[j] > 20.f ? v0[j] : log1pf(__expf(v0[j])); v1[j] = v1[j] > 20.f ? v1[j] : log1pf(__expf(v1[j])); }
                    *(f32x4*)rowp = v0; *(f32x4*)(rowp + 4) = v1; }
        }
    }
};
struct EpiP1b {
    static constexpr bool PERM = true;
    bf16_t* QKV; bf16_t* GATES; const float* ROPE;
    DI void operator()(AccRef acc, const Unit& u, int wr, int wc, int fr, int fq) const {
        const int row0 = u.pm * 256 + wr * 64 + fr;
        const bool isg = u.pn >= 12;
        bf16_t* base = isg ? GATES : QKV; const int ld = isg ? DIN : XBCW; const int col0 = (isg ? u.pn - 12 : u.pn) * 256 + wc * 32 + 8 * fq;
        const bool rope = (u.pn < 8) && ((wc & 1) == 0);
        const float sc = (u.pn < 4) ? QSCALE : 1.f;
#pragma unroll
        for (int ai = 0; ai < 2; ++ai)
#pragma unroll
            for (int m = 0; m < 4; ++m) { const int row = row0 + ai * 128 + m * 16; bf16_t* rowp = base + (size_t)row * ld + col0;
                f32x4 c0v, c1v, s0v, s1v;
                if (rope) { const float* rp = ROPE + (size_t)row * 16; c0v = *(const f32x4*)rp; c1v = *(const f32x4*)(rp + 4); s0v = *(const f32x4*)(rp + 8); s1v = *(const f32x4*)(rp + 12);
                    if (fq == 1) { s0v = -s0v; s1v = -s1v; } }
#pragma unroll
                for (int bj = 0; bj < 2; ++bj) { f32x4 v0 = acc[ai][bj][m][0], v1 = acc[ai][bj][m][1];
                    if (isg) {
#pragma unroll
                        for (int j = 0; j < 4; ++j) { v0[j] = sigmoid_f(v0[j]); v1[j] = sigmoid_f(v1[j]); }
                    } else if (rope) {
                        f32x4 p0, p1;
#pragma unroll
                        for (int j = 0; j < 4; ++j) { p0[j] = __shfl_xor(v0[j], 16); p1[j] = __shfl_xor(v1[j], 16); }
                        if (fq < 2) { v0 = v0 * c0v - p0 * s0v; v1 = v1 * c1v - p1 * s1v; }
                    }
                    v0 = v0 * sc; v1 = v1 * sc;
                    st8(rowp + bj * 128, v0, v1); } }
    }
};
struct EpiSsmOut {
    static constexpr bool PERM = true;
    bf16_t* MIXIN; const bf16_t* GATES;
    DI void operator()(AccRef acc, const Unit& u, int wr, int wc, int fr, int fq) const {
        const int row0 = u.pm * 256 + wr * 64 + fr, col0 = u.pn * 256 + wc * 32 + 8 * fq;
#pragma unroll
        for (int ai = 0; ai < 2; ++ai)
#pragma unroll
            for (int m = 0; m < 4; ++m) { const int row = row0 + ai * 128 + m * 16;
#pragma unroll
                for (int bj = 0; bj < 2; ++bj) { const u32x4 gw = *(const u32x4*)(GATES + (size_t)row * DIN + col0 + bj * 128);
                    f32x4 v0 = acc[ai][bj][m][0], v1 = acc[ai][bj][m][1];
                    v0[0] *= bflo(gw.x); v0[1] *= bfhi(gw.x); v0[2] *= bflo(gw.y); v0[3] *= bfhi(gw.y); v1[0] *= bflo(gw.z); v1[1] *= bfhi(gw.z); v1[2] *= bflo(gw.w); v1[3] *= bfhi(gw.w);
                    st8(MIXIN + (size_t)row * DM + col0 + bj * 128, v0, v1); } }
    }
};
struct EpiAttOut {
    static constexpr bool PERM = true;
    bf16_t* MIXIN; const bf16_t* GATES;
    DI void operator()(AccRef acc, const Unit& u, int wr, int wc, int fr, int fq) const {
        const int row0 = u.pm * 256 + wr * 64 + fr, col0 = u.pn * 256 + wc * 32 + 8 * fq;
#pragma unroll
        for (int ai = 0; ai < 2; ++ai)
#pragma unroll
            for (int m = 0; m < 4; ++m) { const int row = row0 + ai * 128 + m * 16;
#pragma unroll
                for (int bj = 0; bj < 2; ++bj) { const u32x4 gw = *(const u32x4*)(GATES + (size_t)row * DIN + DM + col0 + bj * 128);
                    bf16_t* mp = MIXIN + (size_t)row * DM + col0 + bj * 128; const u32x4 pw = *(const u32x4*)mp;
                    f32x4 v0 = acc[ai][bj][m][0], v1 = acc[ai][bj][m][1];
                    v0[0] = v0[0] * bflo(gw.x) + bflo(pw.x); v0[1] = v0[1] * bfhi(gw.x) + bfhi(pw.x); v0[2] = v0[2] * bflo(gw.y) + bflo(pw.y); v0[3] = v0[3] * bfhi(gw.y) + bfhi(pw.y);
                    v1[0] = v1[0] * bflo(gw.z) + bflo(pw.z); v1[1] = v1[1] * bfhi(gw.z) + bfhi(pw.z); v1[2] = v1[2] * bflo(gw.w) + bflo(pw.w); v1[3] = v1[3] * bfhi(gw.w) + bfhi(pw.w);
                    st8(mp, v0, v1); } }
    }
};
struct EpiF32 {
    static constexpr bool PERM = false;
    float* O;
    DI void operator()(AccRef acc, const Unit& u, int wr, int wc, int fr, int fq) const {
        const int row0 = u.pm * 256 + wr * 64 + fr, col0 = u.pn * 256 + wc * 32 + 4 * fq;
#pragma unroll
        for (int ai = 0; ai < 2; ++ai)
#pragma unroll
            for (int m = 0; m < 4; ++m) { float* rowp = O + (size_t)(row0 + ai * 128 + m * 16) * DM + col0;
#pragma unroll
                for (int bj = 0; bj < 2; ++bj)
#pragma unroll
                    for (int n = 0; n < 2; ++n) *(f32x4*)(rowp + bj * 128 + n * 16) = acc[ai][bj][m][n]; }
    }
};
struct EpiSwiglu {
    static constexpr bool PERM = true;
    bf16_t* HID;
    DI void operator()(AccRef acc, const Unit& u, int wr, int wc, int fr, int fq) const {
        const int row0 = u.pm * 256 + wr * 64 + fr, col0 = u.pn * 128 + wc * 32 + 8 * fq;
#pragma unroll
        for (int ai = 0; ai < 2; ++ai)
#pragma unroll
            for (int m = 0; m < 4; ++m) { f32x4 v0, v1;
#pragma unroll
                for (int j = 0; j < 4; ++j) { v0[j] = silu_f(acc[ai][0][m][0][j]) * acc[ai][1][m][0][j]; v1[j] = silu_f(acc[ai][0][m][1][j]) * acc[ai][1][m][1][j]; }
                st8(HID + (size_t)(row0 + ai * 128 + m * 16) * FFH + col0, v0, v1); }
    }
};

DI float wave_sum(float v) {
#pragma unroll
    for (int o = 1; o < 64; o <<= 1) v += __shfl_xor(v, o);
    return v;
}
DI void transpose_item(const float* W, int ldw, int src_n0, int k0, bf16_t* WT, int ldt, int dst_row0, const float* kscale, LAS float* scr, int lane) {
#pragma unroll 8
    for (int i = 0; i < 32; ++i) { const int kk = 2 * i + (lane >> 5); float v = W[(size_t)(k0 + kk) * ldw + src_n0 + (lane & 31)]; if (kscale) v *= kscale[k0 + kk]; scr[kk * 33 + (lane & 31)] = v; }
    asm volatile("s_waitcnt lgkmcnt(0)" ::: "memory");
    const int c = lane & 7;
#pragma unroll
    for (int j = 0; j < 4; ++j) { const int n = (lane >> 3) + 8 * j; const LAS float* s = scr + (8 * c) * 33 + n;
        u32x4 o; o.x = cvtpk(s[0 * 33], s[1 * 33]); o.y = cvtpk(s[2 * 33], s[3 * 33]); o.z = cvtpk(s[4 * 33], s[5 * 33]); o.w = cvtpk(s[6 * 33], s[7 * 33]);
        *(u32x4*)(WT + (size_t)(dst_row0 + n) * ldt + k0 + 8 * c) = o; }
    asm volatile("s_waitcnt lgkmcnt(0)" ::: "memory");
}
DI void rms_row_to_bf16(const float* xrow, const float* w, bf16_t* orow, int lane) {
    const f32x4* xr = (const f32x4*)xrow + lane; const f32x4* wr_ = (const f32x4*)w + lane;
    f32x4 v[4]; float s = 0.f;
#pragma unroll
    for (int j = 0; j < 4; ++j) { v[j] = xr[64 * j]; s += (v[j].x * v[j].x + v[j].y * v[j].y) + (v[j].z * v[j].z + v[j].w * v[j].w); }
    const float rstd = rsqrtf(wave_sum(s) * (1.f / DM) + EPS);
    u32x2* o8 = (u32x2*)orow + lane;
#pragma unroll
    for (int j = 0; j < 4; ++j) { const f32x4 g = wr_[64 * j]; u32x2 o; o.x = cvtpk(v[j].x * rstd * g.x, v[j].y * rstd * g.y); o.y = cvtpk(v[j].z * rstd * g.z, v[j].w * rstd * g.w); o8[64 * j] = o; }
}

DI void p0_prologue(const Params& P, LAS unsigned char* lds, int G) {
    const int tid = otid(), lane = tid & 63, wave = tid >> 6;
    LAS float* scr = (LAS float*)(lds + wave * 16384);
    const int gw = blockIdx.x * 8 + wave, NGW = G * 8;
    unsigned char* ws = P.ws;
    bf16_t* Win = (bf16_t*)(ws + WS_WIN); bf16_t* Wssm = (bf16_t*)(ws + WS_WSSM); bf16_t* Watt = (bf16_t*)(ws + WS_WATT); bf16_t* Wmix = (bf16_t*)(ws + WS_WMIX);
    bf16_t* Wgu = (bf16_t*)(ws + WS_WGU); bf16_t* Wdn = (bf16_t*)(ws + WS_WDN);
    constexpr int INC = 10272;
    constexpr int I_IN = 16 * 320, I_DT = 16, I_SSM = 32 * 32, I_ATT = 16 * 32, I_MIX = 16 * 32, I_G = 16 * 88, I_U = 16 * 88, I_D = 44 * 32;
    constexpr int NIT = I_IN + I_DT + I_SSM + I_ATT + I_MIX + I_G + I_U + I_D;
    for (int it = gw; it < NIT; it += NGW) {
        int r = it;
        if (r < I_IN) { const int kb = r / 320, nb = r % 320; const int n0 = nb * 32;
            const int src = n0 < 5120 ? n0 : n0 + 32; const int dst = n0 < 5120 ? n0 : n0 + 256;
            transpose_item(P.w_in, INC, src, kb * 64, Win, DM, dst, nullptr, scr, lane); continue; } r -= I_IN;
        if (r < I_DT) { transpose_item(P.w_in, INC, 5120, r * 64, Win, DM, 5120, nullptr, scr, lane); continue; } r -= I_DT;
        if (r < I_SSM) { const int kb = r / 32, nb = r % 32; transpose_item(P.w_ssm_out, DM, nb * 32, kb * 64, Wssm, DIN, nb * 32, P.ssm_norm_w, scr, lane); continue; } r -= I_SSM;
        if (r < I_ATT) { const int kb = r / 32, nb = r % 32; transpose_item(P.w_attn_out, DM, nb * 32, kb * 64, Watt, DM, nb * 32, nullptr, scr, lane); continue; } r -= I_ATT;
        if (r < I_MIX) { const int kb = r / 32, nb = r % 32; transpose_item(P.w_mix, DM, nb * 32, kb * 64, Wmix, DM, nb * 32, nullptr, scr, lane); continue; } r -= I_MIX;
        if (r < I_G) { const int kb = r / 88, nb = r % 88; const int n0 = nb * 32; transpose_item(P.w_gate, FFH, n0, kb * 64, Wgu, DM, 256 * (n0 >> 7) + (n0 & 127), nullptr, scr, lane); continue; } r -= I_G;
        if (r < I_U) { const int kb = r / 88, nb = r % 88; const int n0 = nb * 32; transpose_item(P.w_up, FFH, n0, kb * 64, Wgu, DM, 256 * (n0 >> 7) + 128 + (n0 & 127), nullptr, scr, lane); continue; } r -= I_U;
        { const int kb = r / 32, nb = r % 32; transpose_item(P.w_down, DM, nb * 32, kb * 64, Wdn, FFH, nb * 32, nullptr, scr, lane); }
    }
    bf16_t* XN = (bf16_t*)(ws + WS_XN);
    for (int m = gw; m < T_TOK; m += NGW) rms_row_to_bf16(P.x + (size_t)m * DM, P.n_pre_mix, XN + (size_t)m * DM, lane);
    float* ROPE = (float*)(ws + WS_ROPE);
    for (int e = blockIdx.x * 512 + tid; e < T_TOK * 8; e += G * 512) {
        const int t = e >> 3, i = e & 7;
        const float invf = i == 0 ? 1.0f : i == 1 ? 0.1939227432012558f : i == 2 ? 0.03760603070259094f : i == 3 ? 0.007292664609849453f : i == 4 ? 0.0014142135623842478f
                          : i == 5 ? 0.00027424818836152554f : i == 6 ? 5.318296098266728e-05f : 1.0313386155758053e-05f;
        const float ang = (float)P.pos[t] * invf;
        const double a = (double)ang; const double k = rint(a * 0.15915494309189535); const double rr = a - k * 6.283185307179586;
        const float rf = (float)rr;
        ROPE[t * 16 + i] = __cosf(rf); ROPE[t * 16 + 8 + i] = __sinf(rf);
    }
}

DI s16x4 trrd(const LAS unsigned char* p) { return __builtin_bit_cast(s16x4, __builtin_amdgcn_ds_read_tr16_b64_v4i16((LAS s16x4*)p)); }
DI bf16x8 cat8(s16x4 lo, s16x4 hi) { return __builtin_shufflevector(lo, hi, 0, 1, 2, 3, 4, 5, 6, 7); }
#define MFMA32(a, b, c) __builtin_amdgcn_mfma_f32_32x32x16_bf16((a), (b), (c), 0, 0, 0)
DI int crow(int i, int hi) { return (i & 3) + 8 * (i >> 2) + 4 * hi; }

constexpr int SS_BC = 272, SS_X = 144;
constexpr int L_CS = 0, L_BS = L_CS + 128 * SS_BC, L_HS = L_BS + 128 * SS_BC, L_XS = L_HS + 64 * SS_BC, L_XW = L_XS + 128 * SS_X, L_DT = L_XW + 128 * SS_X, L_DA = L_DT + 512, L_ACS = L_DA + 512, L_SSD_END = L_ACS + 512;
static_assert(L_SSD_END <= 131072, "ssd lds");

template <int R> DI void conv_rows(const bf16_t* XBC, int t0, int r0, bool first, int col, const float* conv_w, const float* conv_b, float (&outv)[R][8]) {
    u32x4 in[R + 3];
#pragma unroll
    for (int i = 0; i < R + 3; ++i) { const int rr = r0 - 3 + i; if (first && rr < 0) in[i] = (u32x4){0u, 0u, 0u, 0u}; else in[i] = *(const u32x4*)(XBC + (size_t)(t0 + rr) * XBCW + col); }
    float w[4][8], bsv[8];
#pragma unroll
    for (int j = 0; j < 4; ++j) { const f32x4 a = *(const f32x4*)(conv_w + j * XBCW + col), b = *(const f32x4*)(conv_w + j * XBCW + col + 4);
        w[j][0] = a.x; w[j][1] = a.y; w[j][2] = a.z; w[j][3] = a.w; w[j][4] = b.x; w[j][5] = b.y; w[j][6] = b.z; w[j][7] = b.w; }
    { const f32x4 a = *(const f32x4*)(conv_b + col), b = *(const f32x4*)(conv_b + col + 4); bsv[0] = a.x; bsv[1] = a.y; bsv[2] = a.z; bsv[3] = a.w; bsv[4] = b.x; bsv[5] = b.y; bsv[6] = b.z; bsv[7] = b.w; }
#pragma unroll
    for (int r = 0; r < R; ++r) {
#pragma unroll
        for (int c = 0; c < 8; ++c) outv[r][c] = bsv[c];
#pragma unroll
        for (int j = 0; j < 4; ++j) { const u32x4 v = in[r + j];
            outv[r][0] += w[j][0] * bflo(v.x); outv[r][1] += w[j][1] * bfhi(v.x); outv[r][2] += w[j][2] * bflo(v.y); outv[r][3] += w[j][3] * bfhi(v.y);
            outv[r][4] += w[j][4] * bflo(v.z); outv[r][5] += w[j][5] * bfhi(v.z); outv[r][6] += w[j][6] * bflo(v.w); outv[r][7] += w[j][7] * bfhi(v.w); }
#pragma unroll
        for (int c = 0; c < 8; ++c) outv[r][c] = silu_f(outv[r][c]);
    }
}

DI void ssd_unit(const Params& P, LAS unsigned char* lds, int b, int h) {
    const int tid = otid(), lane = tid & 63, wid = __builtin_amdgcn_readfirstlane(tid >> 6), r32 = lane & 31, hi = lane >> 5;
    const int q4 = (lane & 15) >> 2, p4 = lane & 3, g1 = (lane >> 4) & 1;
    const int g = h >> 3;
    bf16_t* ZY = (bf16_t*)(P.ws + WS_ZY); const bf16_t* XBC = (const bf16_t*)(P.ws + WS_R96); const float* DT = (const float*)(P.ws + WS_DT);
    const float Ah = -__expf(P.a_log[h]), Dh = P.d_skip[h];
    LAS float* sm_dt = (LAS float*)(lds + L_DT); LAS float* sm_da = (LAS float*)(lds + L_DA); LAS float* sm_acs = (LAS float*)(lds + L_ACS);
    const int pb = wid & 1, lb = wid >> 1;
    f32x16 hacc;
#pragma unroll
    for (int i = 0; i < 16; ++i) hacc[i] = 0.f;
    for (int c = 0; c < 16; ++c) {
        const int t0 = b * SEQ + c * 128; const bool first = (c == 0);
        if (tid < 128) { const float dtv = DT[(size_t)(t0 + tid) * NHS + h]; sm_dt[tid] = dtv; sm_da[tid] = dtv * Ah; }
        __syncthreads();
        if (tid < 128) { float s = 0.f; for (int i = 0; i <= tid; ++i) s += sm_da[i]; sm_acs[tid] = s; }
        __syncthreads();
        const float a_end = sm_acs[127];
        { const int cgp = tid & 31, rs = tid >> 5; const bool isB = cgp < 16; const int col = DIN + (isB ? 0 : 512) + g * 128 + (cgp & 15) * 8; const int r0 = rs * 8;
            float ov[8][8]; conv_rows<8>(XBC, t0, r0, first, col, P.conv_w, P.conv_b, ov);
            LAS unsigned char* dst = lds + (isB ? L_BS : L_CS) + (cgp & 15) * 16;
#pragma unroll
            for (int r = 0; r < 8; ++r) { u32x4 w; w.x = cvtpk(ov[r][0], ov[r][1]); w.y = cvtpk(ov[r][2], ov[r][3]); w.z = cvtpk(ov[r][4], ov[r][5]); w.w = cvtpk(ov[r][6], ov[r][7]);
                *(LAS u32x4*)(dst + (r0 + r) * SS_BC) = w; } }
        { const int cgx = tid & 7, rs = tid >> 3; const int col = h * 64 + cgx * 8; const int r0 = rs * 2;
            float ov[2][8]; conv_rows<2>(XBC, t0, r0, first, col, P.conv_w, P.conv_b, ov);
#pragma unroll
            for (int r = 0; r < 2; ++r) { const int l = r0 + r; const float wl = sm_dt[l] * __expf(a_end - sm_acs[l]);
                u32x4 w; w.x = cvtpk(ov[r][0], ov[r][1]); w.y = cvtpk(ov[r][2], ov[r][3]); w.z = cvtpk(ov[r][4], ov[r][5]); w.w = cvtpk(ov[r][6], ov[r][7]);
                *(LAS u32x4*)(lds + L_XS + l * SS_X + cgx * 16) = w;
                w.x = cvtpk(ov[r][0] * wl, ov[r][1] * wl); w.y = cvtpk(ov[r][2] * wl, ov[r][3] * wl); w.z = cvtpk(ov[r][4] * wl, ov[r][5] * wl); w.w = cvtpk(ov[r][6] * wl, ov[r][7] * wl);
                *(LAS u32x4*)(lds + L_XW + l * SS_X + cgx * 16) = w; } }
        {
#pragma unroll
            for (int i = 0; i < 16; ++i) { const int p = 32 * pb + crow(i, hi), n = 32 * lb + r32; *(LAS bf16_t*)(lds + L_HS + p * SS_BC + n * 2) = (bf16_t)(cvtpk(hacc[i], 0.f) & 0xffffu); } }
        __syncthreads();
        bf16x8 cf[8];
#pragma unroll
        for (int ks = 0; ks < 8; ++ks) cf[ks] = *(const LAS bf16x8*)(lds + L_CS + (32 * lb + r32) * SS_BC + (16 * ks + 8 * hi) * 2);
        f32x16 acc;
#pragma unroll
        for (int i = 0; i < 16; ++i) acc[i] = 0.f;
#pragma unroll
        for (int ks = 0; ks < 8; ++ks) { const bf16x8 a = *(const LAS bf16x8*)(lds + L_HS + (32 * pb + r32) * SS_BC + (16 * ks + 8 * hi) * 2); acc = MFMA32(a, cf[ks], acc); }
        const float acs_l = sm_acs[32 * lb + r32];
        { const float ea = __expf(acs_l);
#pragma unroll
          for (int i = 0; i < 16; ++i) acc[i] *= ea; }
        for (int sb = 0; sb <= lb; ++sb) {
            f32x16 st;
#pragma unroll
            for (int i = 0; i < 16; ++i) st[i] = 0.f;
#pragma unroll
            for (int ks = 0; ks < 8; ++ks) { const bf16x8 a = *(const LAS bf16x8*)(lds + L_BS + (32 * sb + r32) * SS_BC + (16 * ks + 8 * hi) * 2); st = MFMA32(a, cf[ks], st); }
            const int l = 32 * lb + r32;
#pragma unroll
            for (int i = 0; i < 16; ++i) { const int s = 32 * sb + crow(i, hi); float v = st[i] * __expf(acs_l - sm_acs[s]) * sm_dt[s]; v = (s <= l) ? v : 0.f; if (s == l) v += Dh; st[i] = v; }
#pragma unroll
            for (int k2 = 0; k2 < 2; ++k2) {
                u32x4 mw; mw.x = cvtpk(st[8 * k2 + 0], st[8 * k2 + 1]); mw.y = cvtpk(st[8 * k2 + 2], st[8 * k2 + 3]); mw.z = cvtpk(st[8 * k2 + 4], st[8 * k2 + 5]); mw.w = cvtpk(st[8 * k2 + 6], st[8 * k2 + 7]);
                const LAS unsigned char* xp = lds + L_XS + (32 * sb + 16 * k2 + 4 * hi + q4) * SS_X + (32 * pb + 16 * g1) * 2 + 8 * p4;
                const bf16x8 a = cat8(trrd(xp), trrd(xp + 8 * SS_X));
                acc = MFMA32(a, __builtin_bit_cast(bf16x8, mw), acc);
            }
        }
        {
            const size_t trow = (size_t)(t0 + 32 * lb + r32) * DIN + h * 64 + 32 * pb + 4 * hi;
#pragma unroll
            for (int g4 = 0; g4 < 4; ++g4) { bf16_t* zp = ZY + trow + 8 * g4; const u32x2 zw = *(const u32x2*)zp;
                u32x2 o; o.x = cvtpk(acc[4 * g4 + 0] * bflo(zw.x), acc[4 * g4 + 1] * bfhi(zw.x)); o.y = cvtpk(acc[4 * g4 + 2] * bflo(zw.y), acc[4 * g4 + 3] * bfhi(zw.y));
                *(u32x2*)zp = o; }
        }
        { const float ee = __expf(a_end);
#pragma unroll
          for (int i = 0; i < 16; ++i) hacc[i] *= ee; }
#pragma unroll
        for (int ks = 0; ks < 8; ++ks) {
            const LAS unsigned char* xp = lds + L_XW + (16 * ks + 8 * hi + q4) * SS_X + (32 * pb + 16 * g1) * 2 + 8 * p4;
            const LAS unsigned char* bp = lds + L_BS + (16 * ks + 8 * hi + q4) * SS_BC + (32 * lb + 16 * g1) * 2 + 8 * p4;
            const bf16x8 a = cat8(trrd(xp), trrd(xp + 4 * SS_X));
            const bf16x8 bb = cat8(trrd(bp), trrd(bp + 4 * SS_BC));
            hacc = MFMA32(a, bb, hacc);
        }
        __syncthreads();
    }
}

constexpr int AT_KS = 144, AT_VS = 288;
constexpr int LA_K = 0, LA_V = LA_K + 2 * 64 * AT_KS, LA_ST = LA_V + 2 * 64 * AT_VS, LA_END = LA_ST + 8 * 32 * 64 * 4;
static_assert(LA_END <= 131072 - 64, "attn lds");

DI void attn_unit(const Params& P, LAS unsigned char* lds, int b, int hh, int qb, float lam) {
    const int tid = otid(), lane = tid & 63, wid = __builtin_amdgcn_readfirstlane(tid >> 6), r32 = lane & 31, hi = lane >> 5;
    const int q4 = (lane & 15) >> 2, p4 = lane & 3, g1 = (lane >> 4) & 1;
    bf16_t* QKV = (bf16_t*)(P.ws + WS_R96);
    const size_t rowbase = (size_t)b * SEQ; const int q0 = qb * 256;
    const int qmin_w = q0 + wid * 32;
    const int ntile = (q0 + 256) / 64;
    LAS unsigned* stash = (LAS unsigned*)(lds + LA_ST) + wid * 2048 + lane;
    const int krow_ = tid >> 3, kch = tid & 7, vrow = tid >> 4, vch = tid & 15;
    for (int sub = 0; sub < 2; ++sub) {
        const bf16_t* Kg = QKV + rowbase * XBCW + DM + hh * 128 + sub * 64 + kch * 8;
        const bf16_t* Vg = QKV + rowbase * XBCW + 2 * DM + hh * 128 + vch * 8;
        bf16x8 qf[4];
        { const bf16_t* Qg = QKV + (rowbase + qmin_w + r32) * XBCW + hh * 128 + sub * 64 + hi * 8;
#pragma unroll
          for (int d0 = 0; d0 < 4; ++d0) qf[d0] = *(const bf16x8*)(Qg + d0 * 16); }
        float mrun = -1e30f, lrun = 0.f;
        f32x16 o[4];
#pragma unroll
        for (int e = 0; e < 4; ++e)
#pragma unroll
            for (int i = 0; i < 16; ++i) o[e][i] = 0.f;
        u32x4 kreg, vreg0, vreg1;
        kreg = *(const u32x4*)(Kg + (size_t)krow_ * XBCW); vreg0 = *(const u32x4*)(Vg + (size_t)vrow * XBCW); vreg1 = *(const u32x4*)(Vg + (size_t)(vrow + 32) * XBCW);
        for (int j = 0; j < ntile; ++j) {
            LAS unsigned char* Ks = lds + LA_K + (j & 1) * 64 * AT_KS; LAS unsigned char* Vs = lds + LA_V + (j & 1) * 64 * AT_VS;
            *(LAS u32x4*)(Ks + krow_ * AT_KS + kch * 16) = kreg;
            *(LAS u32x4*)(Vs + vrow * AT_VS + vch * 16) = vreg0; *(LAS u32x4*)(Vs + (vrow + 32) * AT_VS + vch * 16) = vreg1;
            __syncthreads();
            if (j + 1 < ntile) { const size_t ro = (size_t)(j + 1) * 64;
                kreg = *(const u32x4*)(Kg + (ro + krow_) * XBCW); vreg0 = *(const u32x4*)(Vg + (ro + vrow) * XBCW); vreg1 = *(const u32x4*)(Vg + (ro + vrow + 32) * XBCW); }
            if (64 * j <= qmin_w + 31) {
                f32x16 s0, s1;
#pragma unroll
                for (int i = 0; i < 16; ++i) { s0[i] = 0.f; s1[i] = 0.f; }
#pragma unroll
                for (int d0 = 0; d0 < 4; ++d0) {
                    const bf16x8 a0 = *(const LAS bf16x8*)(Ks + r32 * AT_KS + (d0 * 16 + hi * 8) * 2);
                    const bf16x8 a1 = *(const LAS bf16x8*)(Ks + (32 + r32) * AT_KS + (d0 * 16 + hi * 8) * 2);
                    s0 = MFMA32(a0, qf[d0], s0); s1 = MFMA32(a1, qf[d0], s1);
                }
                if (64 * j + 63 > qmin_w) {
                    const int qg = qmin_w + r32;
#pragma unroll
                    for (int i = 0; i < 16; ++i) { const int kv = 64 * j + crow(i, hi); if (kv > qg) s0[i] = -INFINITY; if (kv + 32 > qg) s1[i] = -INFINITY; }
                }
                float mx = s0[0];
#pragma unroll
                for (int i = 1; i < 16; ++i) mx = fmaxf(mx, s0[i]);
#pragma unroll
                for (int i = 0; i < 16; ++i) mx = fmaxf(mx, s1[i]);
                mx = fmaxf(mx, __shfl_xor(mx, 32));
                const float mnew = fmaxf(mrun, mx); const float alpha = exp2f(mrun - mnew); mrun = mnew;
                float rs = 0.f;
#pragma unroll
                for (int i = 0; i < 16; ++i) { s0[i] = exp2f(s0[i] - mnew); s1[i] = exp2f(s1[i] - mnew); rs += s0[i] + s1[i]; }
                lrun = lrun * alpha + rs;
#pragma unroll
                for (int e = 0; e < 4; ++e)
#pragma unroll
                    for (int i = 0; i < 16; ++i) o[e][i] *= alpha;
                bf16x8 pf[2][2];
#pragma unroll
                for (int k2 = 0; k2 < 2; ++k2) {
                    u32x4 w; w.x = cvtpk(s0[8 * k2 + 0], s0[8 * k2 + 1]); w.y = cvtpk(s0[8 * k2 + 2], s0[8 * k2 + 3]); w.z = cvtpk(s0[8 * k2 + 4], s0[8 * k2 + 5]); w.w = cvtpk(s0[8 * k2 + 6], s0[8 * k2 + 7]);
                    pf[0][k2] = __builtin_bit_cast(bf16x8, w);
                    w.x = cvtpk(s1[8 * k2 + 0], s1[8 * k2 + 1]); w.y = cvtpk(s1[8 * k2 + 2], s1[8 * k2 + 3]); w.z = cvtpk(s1[8 * k2 + 4], s1[8 * k2 + 5]); w.w = cvtpk(s1[8 * k2 + 6], s1[8 * k2 + 7]);
                    pf[1][k2] = __builtin_bit_cast(bf16x8, w);
                }
#pragma unroll
                for (int e = 0; e < 4; ++e)
#pragma unroll
                    for (int blk = 0; blk < 2; ++blk)
#pragma unroll
                        for (int k2 = 0; k2 < 2; ++k2) {
                            const LAS unsigned char* vp = Vs + (32 * blk + 16 * k2 + 4 * hi + q4) * AT_VS + (32 * e + 16 * g1) * 2 + 8 * p4;
                            const bf16x8 a = cat8(trrd(vp), trrd(vp + 8 * AT_VS));
                            o[e] = MFMA32(a, pf[blk][k2], o[e]);
                            if (k2 == 1) __builtin_amdgcn_sched_barrier(0);
                        }
            }
        }
        const float ltot = lrun + __shfl_xor(lrun, 32); const float inv = 1.f / ltot;
        if (sub == 0) {
#pragma unroll
            for (int e = 0; e < 4; ++e)
#pragma unroll
                for (int k = 0; k < 8; ++k) stash[(e * 8 + k) * 64] = cvtpk(o[e][2 * k] * inv, o[e][2 * k + 1] * inv);
        } else {
            float ss = 0.f;
#pragma unroll
            for (int e = 0; e < 4; ++e)
#pragma unroll
                for (int k = 0; k < 8; ++k) { const unsigned w = stash[(e * 8 + k) * 64];
                    const float v0 = bflo(w) - lam * (o[e][2 * k] * inv), v1 = bfhi(w) - lam * (o[e][2 * k + 1] * inv);
                    o[e][2 * k] = v0; o[e][2 * k + 1] = v1; ss += v0 * v0 + v1 * v1; }
            ss += __shfl_xor(ss, 32);
            const float rstd = rsqrtf(ss * (1.f / 128.f) + EPS) * (1.f - LAM_INIT);
            bf16_t* Og = QKV + (rowbase + qmin_w + r32) * XBCW + hh * 128 + 4 * hi;
#pragma unroll
            for (int e = 0; e < 4; ++e)
#pragma unroll
                for (int g4 = 0; g4 < 4; ++g4) { const int ec = 32 * e + 8 * g4 + 4 * hi; const f32x4 sw = *(const f32x4*)(P.subln_w + ec);
                    u32x2 w; w.x = cvtpk(o[e][4 * g4 + 0] * rstd * sw.x, o[e][4 * g4 + 1] * rstd * sw.y); w.y = cvtpk(o[e][4 * g4 + 2] * rstd * sw.z, o[e][4 * g4 + 3] * rstd * sw.w);
                    *(u32x2*)(Og + 32 * e + 8 * g4) = w; }
        }
        __syncthreads();
    }
}

DI void ynorm_row(bf16_t* yrow, int lane) {
    u32x4* p = (u32x4*)yrow + lane * 4; u32x4 v[4]; float ss = 0.f;
#pragma unroll
    for (int j = 0; j < 4; ++j) { v[j] = p[j];
        const float a0 = bflo(v[j].x), a1 = bfhi(v[j].x), a2 = bflo(v[j].y), a3 = bfhi(v[j].y), a4 = bflo(v[j].z), a5 = bfhi(v[j].z), a6 = bflo(v[j].w), a7 = bfhi(v[j].w);
        ss += (a0 * a0 + a1 * a1) + (a2 * a2 + a3 * a3) + (a4 * a4 + a5 * a5) + (a6 * a6 + a7 * a7); }
    ss += __shfl_xor(ss, 1); ss += __shfl_xor(ss, 2); ss += __shfl_xor(ss, 4); ss += __shfl_xor(ss, 8);
    const float r = rsqrtf(ss * (1.f / 512.f) + EPS);
#pragma unroll
    for (int j = 0; j < 4; ++j) { u32x4 o;
        o.x = cvtpk(bflo(v[j].x) * r, bfhi(v[j].x) * r); o.y = cvtpk(bflo(v[j].y) * r, bfhi(v[j].y) * r); o.z = cvtpk(bflo(v[j].z) * r, bfhi(v[j].z) * r); o.w = cvtpk(bflo(v[j].w) * r, bfhi(v[j].w) * r);
        p[j] = o; }
}

DI void row_pass5(const float* mixed, const float* x, const float* w1, const float* w2, float* out, bf16_t* h2, int lane) {
    const f32x4* mr = (const f32x4*)mixed + lane; const f32x4* xr = (const f32x4*)x + lane;
    f32x4 v[4]; float s = 0.f;
#pragma unroll
    for (int j = 0; j < 4; ++j) { v[j] = mr[64 * j]; s += (v[j].x * v[j].x + v[j].y * v[j].y) + (v[j].z * v[j].z + v[j].w * v[j].w); }
    const float rstd = rsqrtf(wave_sum(s) * (1.f / DM) + EPS);
    float s2 = 0.f;
#pragma unroll
    for (int j = 0; j < 4; ++j) { const f32x4 g = ((const f32x4*)w1 + lane)[64 * j]; v[j] = xr[64 * j] + v[j] * rstd * g; ((f32x4*)out + lane)[64 * j] = v[j];
        s2 += (v[j].x * v[j].x + v[j].y * v[j].y) + (v[j].z * v[j].z + v[j].w * v[j].w); }
    const float rstd2 = rsqrtf(wave_sum(s2) * (1.f / DM) + EPS);
    u32x2* o8 = (u32x2*)h2 + lane;
#pragma unroll
    for (int j = 0; j < 4; ++j) { const f32x4 g = ((const f32x4*)w2 + lane)[64 * j]; u32x2 o; o.x = cvtpk(v[j].x * rstd2 * g.x, v[j].y * rstd2 * g.y); o.y = cvtpk(v[j].z * rstd2 * g.z, v[j].w * rstd2 * g.w); o8[64 * j] = o; }
}
DI void row_pass8(const float* f, const float* w, float* out, int lane) {
    const f32x4* fr_ = (const f32x4*)f + lane;
    f32x4 v[4]; float s = 0.f;
#pragma unroll
    for (int j = 0; j < 4; ++j) { v[j] = fr_[64 * j]; s += (v[j].x * v[j].x + v[j].y * v[j].y) + (v[j].z * v[j].z + v[j].w * v[j].w); }
    const float rstd = rsqrtf(wave_sum(s) * (1.f / DM) + EPS);
#pragma unroll
    for (int j = 0; j < 4; ++j) { const f32x4 g = ((const f32x4*)w + lane)[64 * j]; f32x4* op = (f32x4*)out + lane + 64 * j; *op = *op + v[j] * rstd * g; }
}

__global__ void __launch_bounds__(512, 2) hybrid_fwd(Params P) {
    extern __shared__ __attribute__((aligned(16))) unsigned char lds_raw[];
    LAS unsigned char* lds = (LAS unsigned char*)lds_raw;
    cg::grid_group grid = cg::this_grid();
    const int G = gridDim.x, NGW = G * 8;
#define PHASE_IDS const int tid = otid(), lane = tid & 63, wave = tid >> 6, gw = blockIdx.x * 8 + wave; (void)tid; (void)lane; (void)wave; (void)gw
    unsigned char* ws = P.ws;
    bf16_t* ZY = (bf16_t*)(ws + WS_ZY); bf16_t* R96 = (bf16_t*)(ws + WS_R96); bf16_t* XN = (bf16_t*)(ws + WS_XN);
    const bf16_t* Win = (const bf16_t*)(ws + WS_WIN); const bf16_t* Wssm = (const bf16_t*)(ws + WS_WSSM); const bf16_t* Watt = (const bf16_t*)(ws + WS_WATT);
    const bf16_t* Wmix = (const bf16_t*)(ws + WS_WMIX); const bf16_t* Wgu = (const bf16_t*)(ws + WS_WGU); const bf16_t* Wdn = (const bf16_t*)(ws + WS_WDN);
    float* DT = (float*)(ws + WS_DT); const float* ROPE = (const float*)(ws + WS_ROPE);
    bf16_t* GATES = (bf16_t*)P.out;
    float* F32 = (float*)(ws + WS_ZY);

    p0_prologue(P, lds, G);
    grid.sync();
    { pg8::Gemm g{XN, Win, T_TOK, N1A, DM, DM}; pg8::StaticOrder S; S.init(T_TOK, N1A, G, (int)blockIdx.x);
      EpiP1a E{ZY, R96, DT, P.dt_bias};
      pg8::gemm_phase<EpiP1a, pg8::StaticOrder, true, true>(lds, g, S, E); }
    grid.sync();
#ifndef NO_SSD
    for (int u = blockIdx.x; u < NB * NHS; u += G) ssd_unit(P, lds, u >> 5, u & 31);
#endif
    grid.sync();
    { pg8::Gemm g{XN, Win + (size_t)N1A * DM, T_TOK, N1B, DM, DM}; pg8::StaticOrder S; S.init(T_TOK, N1B, G, (int)blockIdx.x);
      EpiP1b E{R96, GATES, ROPE};
      pg8::gemm_phase<EpiP1b, pg8::StaticOrder, true, true>(lds, g, S, E); }
    grid.sync();
    {
        PHASE_IDS;
        LAS float* lamp = (LAS float*)(lds + 131072);
        if (wave == 0) { const float a = wave_sum(P.lq1[lane] * P.lk1[lane]), c = wave_sum(P.lq2[lane] * P.lk2[lane]); if (lane == 0) lamp[0] = expf(a) - expf(c) + LAM_INIT; }
        __syncthreads();
        const float lam = lamp[0];
#ifndef NO_ATT
        for (int it = blockIdx.x; it < 256; it += G) {
            const int bh = it >> 2, s = it & 3;
            attn_unit(P, lds, bh >> 3, bh & 7, 7 - s, lam);
            attn_unit(P, lds, bh >> 3, bh & 7, s, lam);
        }
#endif
        for (int m = gw; m < T_TOK; m += NGW) ynorm_row(ZY + (size_t)m * DIN, lane);
    }
    grid.sync();
    { bf16_t* MIXIN = XN;
      { pg8::Gemm g{ZY, Wssm, T_TOK, DM, DIN, DIN}; pg8::StaticOrder S; S.init(T_TOK, DM, G, (int)blockIdx.x); EpiSsmOut E{MIXIN, GATES};
        pg8::gemm_phase<EpiSsmOut, pg8::StaticOrder, true, true>(lds, g, S, E); }
      { pg8::Gemm g{R96, Watt, T_TOK, DM, DM, XBCW}; pg8::StaticOrder S; S.init(T_TOK, DM, G, (int)blockIdx.x); EpiAttOut E{MIXIN, GATES};
        pg8::gemm_phase<EpiAttOut, pg8::StaticOrder, true, true>(lds, g, S, E); } }
    grid.sync();
    { pg8::Gemm g{XN, Wmix, T_TOK, DM, DM, DM}; pg8::StaticOrder S; S.init(T_TOK, DM, G, (int)blockIdx.x); EpiF32 E{F32};
      pg8::gemm_phase<EpiF32, pg8::StaticOrder, true, true>(lds, g, S, E); }
    grid.sync();
    { PHASE_IDS;
    for (int m = gw; m < T_TOK; m += NGW) row_pass5(F32 + (size_t)m * DM, P.x + (size_t)m * DM, P.n_post_mix, P.n_pre_ffn, P.out + (size_t)m * DM, XN + (size_t)m * DM, lane); }
    grid.sync();
    { pg8::Gemm g{XN, Wgu, T_TOK, 2 * FFH, DM, DM}; pg8::StaticOrder S; S.init(T_TOK, 2 * FFH, G, (int)blockIdx.x); EpiSwiglu E{R96};
      pg8::gemm_phase<EpiSwiglu, pg8::StaticOrder, true, true>(lds, g, S, E); }
    grid.sync();
    { pg8::Gemm g{R96, Wdn, T_TOK, DM, FFH, FFH}; pg8::StaticOrder S; S.init(T_TOK, DM, G, (int)blockIdx.x); EpiF32 E{F32};
      pg8::gemm_phase<EpiF32, pg8::StaticOrder, true, true>(lds, g, S, E); }
    grid.sync();
    { PHASE_IDS;
    for (int m = gw; m < T_TOK; m += NGW) row_pass8(F32 + (size_t)m * DM, P.n_post_ffn, P.out + (size_t)m * DM, lane); }
}

extern "C" void kernel_launch(void* const* d_in, const int* in_sizes, int n_in, void* d_out, int out_size, void* d_ws, size_t ws_size, hipStream_t stream) {
    static int grid = 0;
    if (grid == 0) {
        if (n_in != 24 || out_size != T_TOK * DM || ws_size < WS_END) { fprintf(stderr, "kernel_launch: unexpected shapes (n_in %d out %d ws %zu)\n", n_in, out_size, ws_size); grid = -1; return; }
        int dev = 0, cus = 0, per_cu = 0;
        hipGetDevice(&dev); hipDeviceGetAttribute(&cus, hipDeviceAttributeMultiprocessorCount, dev);
        hipFuncSetAttribute((const void*)hybrid_fwd, hipFuncAttributeMaxDynamicSharedMemorySize, LDS_BYTES);
        hipOccupancyMaxActiveBlocksPerMultiprocessor(&per_cu, (const void*)hybrid_fwd, 512, LDS_BYTES);
        if (per_cu < 1) { fprintf(stderr, "kernel_launch: occupancy query says %d blocks/CU\n", per_cu); per_cu = 1; }
        (void)hipGetLastError();
        grid = cus * 1;
    }
    if (grid < 0) return;
    Params p{};
    p.x = (const float*)d_in[0]; p.pos = (const int*)d_in[1]; p.w_in = (const float*)d_in[2]; p.conv_w = (const float*)d_in[3]; p.conv_b = (const float*)d_in[4];
    p.dt_bias = (const float*)d_in[5]; p.a_log = (const float*)d_in[6]; p.d_skip = (const float*)d_in[7]; p.ssm_norm_w = (const float*)d_in[8]; p.w_ssm_out = (const float*)d_in[9];
    p.lq1 = (const float*)d_in[10]; p.lk1 = (const float*)d_in[11]; p.lq2 = (const float*)d_in[12]; p.lk2 = (const float*)d_in[13]; p.subln_w = (const float*)d_in[14];
    p.w_attn_out = (const float*)d_in[15]; p.w_mix = (const float*)d_in[16]; p.n_pre_mix = (const float*)d_in[17]; p.n_post_mix = (const float*)d_in[18];
    p.n_pre_ffn = (const float*)d_in[19]; p.n_post_ffn = (const float*)d_in[20]; p.w_gate = (const float*)d_in[21]; p.w_up = (const float*)d_in[22]; p.w_down = (const float*)d_in[23];
    p.out = (float*)d_out; p.ws = (unsigned char*)d_ws;
    void* args[] = {&p};
    hipError_t e = hipLaunchCooperativeKernel((const void*)hybrid_fwd, dim3(grid), dim3(512), args, LDS_BYTES, stream);
    if (e != hipSuccess) fprintf(stderr, "cooperative launch failed: %s (grid %d)\n", hipGetErrorString(e), grid);
}
```

```cpp
#include <hip/hip_runtime.h>
#include <hip/hip_cooperative_groups.h>
#include <cstdio>
#include <cstdint>
namespace cg = cooperative_groups;

#define LAS __attribute__((address_space(3)))
typedef unsigned short bf16_t;
typedef short bf16x8 __attribute__((ext_vector_type(8)));
typedef short s16x4 __attribute__((ext_vector_type(4)));
typedef float f32x4 __attribute__((ext_vector_type(4)));
typedef float f32x16 __attribute__((ext_vector_type(16)));
typedef unsigned u32x4 __attribute__((ext_vector_type(4)));
typedef unsigned u32x2 __attribute__((ext_vector_type(2)));
typedef float f32x2_t __attribute__((ext_vector_type(2)));
typedef __bf16 bf16x2_t __attribute__((ext_vector_type(2)));
#define DI __device__ __forceinline__

DI int otid() { int t = threadIdx.x; asm volatile("" : "+v"(t)); return t; }
DI int oone() { int t = 1; asm volatile("" : "+s"(t)); return t; }
DI unsigned cvtpk(float lo, float hi) { f32x2_t v = {lo, hi}; bf16x2_t b = __builtin_convertvector(v, bf16x2_t); return __builtin_bit_cast(unsigned, b); }
DI float bflo(unsigned w) { return __uint_as_float(w << 16); }
DI float bfhi(unsigned w) { return __uint_as_float(w & 0xffff0000u); }
DI float silu_f(float x) { return x / (1.f + __expf(-x)); }
DI float sigmoid_f(float x) { return 1.f / (1.f + __expf(-x)); }

constexpr int T_TOK = 16384, SEQ = 2048, DM = 1024, NB = 8;
constexpr int NHS = 32, DIN = 2048, XBCW = 3072, FFH = 2816;
constexpr int N1A = 5376, N1B = 5120, NIN = N1A + N1B;
constexpr float EPS = 1e-6f;
constexpr float QSCALE = 0.125f * 1.4426950408889634f;
constexpr float LAM_INIT = 0.2f;

constexpr size_t MiB = 1u << 20;
constexpr size_t WS_ZY = 0, WS_R96 = 64 * MiB, WS_XN = 160 * MiB, WS_WIN = 192 * MiB, WS_WSSM = 213 * MiB, WS_WATT = 217 * MiB, WS_WMIX = 219 * MiB,
                 WS_WGU = 221 * MiB, WS_WDN = 232 * MiB, WS_DT = 238 * MiB, WS_ROPE = 240 * MiB, WS_BAR = 241 * MiB, WS_END = 242 * MiB;
constexpr int LDS_BYTES = 147456;

struct Params {
    const float* x; const int* pos; const float* w_in; const float* conv_w; const float* conv_b; const float* dt_bias; const float* a_log; const float* d_skip;
    const float* ssm_norm_w; const float* w_ssm_out; const float* lq1; const float* lk1; const float* lq2; const float* lk2; const float* subln_w; const float* w_attn_out;
    const float* w_mix; const float* n_pre_mix; const float* n_post_mix; const float* n_pre_ffn; const float* n_post_ffn; const float* w_gate; const float* w_up; const float* w_down;
    float* out; unsigned char* ws;
};

namespace pg8 {
#define PG8_LAS __attribute__((address_space(3)))
constexpr int BM = 256, BK = 64, HALF = 128, HTB = HALF * BK * 2, STAGE_BYTES = 8 * HTB, NXCD = 8, WGM = 8;
__host__ __device__ __forceinline__ int lds_byte(int r, int c) { const int st = (r >> 4) * 2 + (c >> 5), rr = r & 15, cc = c & 31, ob = rr * 64 + cc * 2; return st * 1024 + (ob ^ (((ob >> 9) & 1) << 5)); }
__host__ __device__ __forceinline__ void stage_rc(int b, int& R, int& C) { const int st = b / 1024, sb = b % 1024, swz = sb ^ (((sb >> 9) & 1) << 5); R = (st >> 1) * 16 + swz / 64; C = (st & 1) * 32 + (swz % 64) / 2; }
__host__ __device__ __forceinline__ int perm32(int rho) { const int n = rho >> 4, i = rho & 15; return 8 * (i >> 2) + 4 * n + (i & 3); }
struct Unit { int pm, pn; };
struct Gemm { const bf16_t* A; const bf16_t* Bt; int M, N, K, lda; };
struct StaticOrder {
    int nM, nN, nwg, G, c;
    __host__ __device__ void init(int M, int N, int G_, int c_) { nM = M / BM; nN = N / BM; nwg = nM * nN; G = G_; c = c_; }
    __host__ __device__ bool next(int i, Unit& u) const {
        const long L = (long)i * G + c; if (L >= nwg) return false;
        int wgid = (int)L; { const int q = nwg / NXCD, r = nwg % NXCD, xcd = wgid % NXCD, off = wgid / NXCD; wgid = (xcd < r ? xcd * (q + 1) : r * (q + 1) + (xcd - r) * q) + off; }
        const int nig = WGM * nN, gid = wgid / nig, fm = gid * WGM, gsz = (nM - fm) < WGM ? (nM - fm) : WGM;
        u.pm = fm + ((wgid % nig) % gsz); u.pn = (wgid % nig) / gsz; return true;
    }
};
template <class Epi, class Sched, bool ALIGN_EPI, bool SP2>
__device__ __forceinline__ void gemm_phase(PG8_LAS unsigned char* lds, const Gemm g, const Sched& S, const Epi& E) {
    const int tid = otid(), wid = __builtin_amdgcn_readfirstlane(tid >> 6), lane = tid & 63, wr = wid >> 2, wc = wid & 3, fr = lane & 15, fq = lane >> 4;
    const int K = g.K, nt = K / BK, lda = g.lda;
    unsigned voffA[2], voffB[2];
#pragma unroll
    for (int i = 0; i < 2; ++i) { int R, C; stage_rc(tid * 16 + i * 8192, R, C); const int Rb = Epi::PERM ? ((R & ~31) + perm32(R & 31)) : R;
        voffA[i] = (unsigned)(R * lda + C) * 2u; voffB[i] = (unsigned)(Rb * K + C) * 2u; }
    const size_t kstep = (size_t)(BK * 2);
    const size_t hstepA = (size_t)HALF * lda * 2, hstepB = (size_t)HALF * K * 2;
    const size_t tstepA = 2 * hstepA, tstepB = 2 * hstepB;
    const unsigned ldsw = (unsigned)wid * 1024u;
    const int aoff = lds_byte(wr * 64 + fr, fq * 8), boff = lds_byte(wc * 32 + fr, fq * 8);
#define PG8_SA(b, h) (((b) * 2 + (h)) * HTB)
#define PG8_SB(b, h) ((4 + (b) * 2 + (h)) * HTB)
#define PG8_STAGE(bufoff, gbase, voff) do { _Pragma("unroll") for (int _i = 0; _i < 2; ++_i) \
        __builtin_amdgcn_global_load_lds((const unsigned*)((const char*)(gbase) + (voff)[_i]), (PG8_LAS unsigned*)(lds + (bufoff) + ldsw + _i * 8192), 16, 0, 0); } while (0)
#define PG8_LDA(dst, b, h) do { _Pragma("unroll") for (int m = 0; m < 4; ++m) _Pragma("unroll") for (int k = 0; k < 2; ++k) dst[m][k] = *(const PG8_LAS bf16x8*)(lds + PG8_SA(b, h) + aoff + m * 2048 + k * 1024); } while (0)
#define PG8_LDB(dst, b, h) do { _Pragma("unroll") for (int n = 0; n < 2; ++n) _Pragma("unroll") for (int k = 0; k < 2; ++k) dst[n][k] = *(const PG8_LAS bf16x8*)(lds + PG8_SB(b, h) + boff + n * 2048 + k * 1024); } while (0)
#define PG8_MMA(ai, bj, At, Bt) do { __builtin_amdgcn_s_setprio(1); _Pragma("unroll") for (int m = 0; m < 4; ++m) _Pragma("unroll") for (int n = 0; n < 2; ++n) _Pragma("unroll") for (int k = 0; k < 2; ++k) \
        acc[ai][bj][m][n] = __builtin_amdgcn_mfma_f32_16x16x32_bf16(Bt[n][k], At[m][k], acc[ai][bj][m][n], 0, 0, 0); __builtin_amdgcn_s_setprio(0); } while (0)
#define PG8_WAIT_V(n) asm volatile("s_waitcnt vmcnt(" #n ")" ::: "memory")
#define PG8_WAIT_L(n) asm volatile("s_waitcnt lgkmcnt(" #n ")" ::: "memory")
#define PG8_BAR __builtin_amdgcn_s_barrier()
#define PG8_SCHED __builtin_amdgcn_sched_barrier(0)
    Unit cur, nxt; int ui = 0;
    if (!S.next(0, cur)) return;
    f32x4 acc[2][2][4][2];
#pragma unroll
    for (int a = 0; a < 2; ++a)
#pragma unroll
        for (int b = 0; b < 2; ++b)
#pragma unroll
            for (int m = 0; m < 4; ++m)
#pragma unroll
                for (int n = 0; n < 2; ++n) acc[a][b][m][n] = (f32x4){0.f, 0.f, 0.f, 0.f};
    bf16x8 At[4][2], B0[2][2], B1[2][2];
    const char* cA = (const char*)g.A + (size_t)cur.pm * tstepA; const char* cB = (const char*)g.Bt + (size_t)cur.pn * tstepB;
    if constexpr (SP2) {
        PG8_STAGE(PG8_SB(0, 0), cB, voffB); PG8_STAGE(PG8_SB(0, 1), cB + hstepB, voffB); PG8_STAGE(PG8_SA(0, 0), cA, voffA); PG8_STAGE(PG8_SA(0, 1), cA + hstepA, voffA);
        if (wr == 1) PG8_BAR;
        PG8_WAIT_V(2); PG8_BAR;
        PG8_STAGE(PG8_SB(1, 0), cB + kstep, voffB); PG8_STAGE(PG8_SA(1, 0), cA + kstep, voffA); PG8_STAGE(PG8_SB(1, 1), cB + hstepB + kstep, voffB);
        PG8_WAIT_V(6); PG8_BAR;
    }
    for (;;) {
        const bool has_next = S.next(ui + 1, nxt);
        const char* nA = has_next ? (const char*)g.A + (size_t)nxt.pm * tstepA : cA; const char* nB = has_next ? (const char*)g.Bt + (size_t)nxt.pn * tstepB : cB;
        for (int t = 0; t < nt; t += 2) {
            const bool last = (t == nt - 2);
            const char* a1 = cA + (size_t)(t + 1) * kstep;
            const char* a2 = last ? nA : cA + (size_t)(t + 2) * kstep; const char* b2 = last ? nB : cB + (size_t)(t + 2) * kstep;
            const char* a3 = a2 + kstep; const char* b3 = b2 + kstep;
            PG8_LDB(B0, 0, 0); PG8_LDB(B1, 0, 1); PG8_SCHED; PG8_LDA(At, 0, 0); PG8_STAGE(PG8_SA(1, 1), a1 + hstepA, voffA);
            PG8_WAIT_V(8); PG8_WAIT_L(0); PG8_BAR; PG8_MMA(0, 0, At, B0); PG8_MMA(0, 1, At, B1); PG8_BAR; PG8_SCHED;
            PG8_LDA(At, 0, 1); PG8_STAGE(PG8_SB(0, 0), b2, voffB); PG8_STAGE(PG8_SB(0, 1), b2 + hstepB, voffB); PG8_STAGE(PG8_SA(0, 0), a2, voffA);
            PG8_WAIT_V(8); PG8_WAIT_L(0); PG8_BAR; PG8_MMA(1, 0, At, B0); PG8_MMA(1, 1, At, B1); PG8_BAR; PG8_SCHED;
            PG8_LDB(B0, 1, 0); PG8_LDB(B1, 1, 1); PG8_SCHED; PG8_LDA(At, 1, 0); PG8_STAGE(PG8_SA(0, 1), a2 + hstepA, voffA);
            PG8_WAIT_V(8); PG8_WAIT_L(0); PG8_BAR; PG8_MMA(0, 0, At, B0); PG8_MMA(0, 1, At, B1); PG8_BAR; PG8_SCHED;
            PG8_LDA(At, 1, 1); PG8_STAGE(PG8_SB(1, 0), b3, voffB); PG8_STAGE(PG8_SB(1, 1), b3 + hstepB, voffB); PG8_STAGE(PG8_SA(1, 0), a3, voffA);
            PG8_WAIT_V(8); PG8_WAIT_L(0); PG8_BAR; PG8_MMA(1, 0, At, B0); PG8_MMA(1, 1, At, B1); PG8_BAR; PG8_SCHED;
        }
        if constexpr (ALIGN_EPI) { if (wr == 0) PG8_BAR; }
        E(acc, cur, wr, wc, fr, fq);
        if (!has_next) break;
#pragma unroll
        for (int a = 0; a < 2; ++a)
#pragma unroll
            for (int b = 0; b < 2; ++b)
#pragma unroll
                for (int m = 0; m < 4; ++m)
#pragma unroll
                    for (int n = 0; n < 2; ++n) acc[a][b][m][n] = (f32x4){0.f, 0.f, 0.f, 0.f};
        cur = nxt; cA = nA; cB = nB; ++ui;
        if constexpr (ALIGN_EPI) { if (wr == 1) PG8_BAR; }
    }
    PG8_WAIT_V(0);
    if constexpr (!ALIGN_EPI) { if (wr == 0) PG8_BAR; }
    PG8_BAR;
#undef PG8_SA
#undef PG8_SB
#undef PG8_STAGE
#undef PG8_LDA
#undef PG8_LDB
#undef PG8_MMA
#undef PG8_WAIT_V
#undef PG8_WAIT_L
#undef PG8_BAR
#undef PG8_SCHED
}
}
using pg8::Unit;
typedef const f32x4 (&AccRef)[2][2][4][2];

DI void st8(bf16_t* p, f32x4 v0, f32x4 v1) { u32x4 w; w.x = cvtpk(v0[0], v0[1]); w.y = cvtpk(v0[2], v0[3]); w.z = cvtpk(v1[0], v1[1]); w.w = cvtpk(v1[2], v1[3]); *(u32x4*)p = w; }

struct EpiP1a {
    static constexpr bool PERM = true;
    bf16_t* ZY; bf16_t* XBC; float* DT; const float* dt_bias;
    DI void operator()(AccRef acc, const Unit& u, int wr, int wc, int fr, int fq) const {
        const int row0 = u.pm * 256 + wr * 64 + fr;
        if (u.pn < 20) {
            const bool isz = u.pn < 8;
            bf16_t* base = isz ? ZY : XBC; const int ld = isz ? DIN : XBCW; const int col0 = (isz ? u.pn : u.pn - 8) * 256 + wc * 32 + 8 * fq;
#pragma unroll
            for (int ai = 0; ai < 2; ++ai)
#pragma unroll
                for (int m = 0; m < 4; ++m) { bf16_t* rowp = base + (size_t)(row0 + ai * 128 + m * 16) * ld + col0;
#pragma unroll
                    for (int bj = 0; bj < 2; ++bj) { f32x4 v0 = acc[ai][bj][m][0], v1 = acc[ai][bj][m][1];
                        if (isz) {
#pragma unroll
                            for (int j = 0; j < 4; ++j) { v0[j] = silu_f(v0[j]); v1[j] = silu_f(v1[j]); } }
                        st8(rowp + bj * 128, v0, v1); } }
        } else if (wc == 0) {
            const int c0 = 8 * fq;
            const f32x4 b0 = *(const f32x4*)(dt_bias + c0), b1 = *(const f32x4*)(dt_bias + c0 + 4);
#pragma unroll
            for (int ai = 0; ai < 2; ++ai)
#pragma unroll
                for (int m = 0; m < 4; ++m) { float* rowp = DT + (size_t)(row0 + ai * 128 + m * 16) * NHS + c0;
                    f32x4 v0 = acc[ai][0][m][0] + b0, v1 = acc[ai][0][m][1] + b1;
#pragma unroll
                    for (int j = 0; j < 4; ++j) { v0[j] = v0[j] > 20.f ? v0[j] : log1pf(__expf(v0[j])); v1[j] = v1[j] > 20.f ? v1[j] : log1pf(__expf(v1[j])); }
                    *(f32x4*)rowp = v0; *(f32x4*)(rowp + 4) = v1; }
        }
    }
};
struct EpiP1b {
    static constexpr bool PERM = true;
    bf16_t* QKV; bf16_t* GATES; const float* ROPE;
    DI void operator()(AccRef acc, const Unit& u, int wr, int wc, int fr, int fq) const {
        const int row0 = u.pm * 256 + wr * 64 + fr;
        const bool isg = u.pn >= 12;
        bf16_t* base = isg ? GATES : QKV; const int ld = isg ? DIN : XBCW; const int col0 = (isg ? u.pn - 12 : u.pn) * 256 + wc * 32 + 8 * fq;
        const bool rope = (u.pn < 8) && ((wc & 1) == 0);
        const float sc = (u.pn < 4) ? QSCALE : 1.f;
#pragma unroll
        for (int ai = 0; ai < 2; ++ai)
#pragma unroll
            for (int m = 0; m < 4; ++m) { const int row = row0 + ai * 128 + m * 16; bf16_t* rowp = base + (size_t)row * ld + col0;
                f32x4 c0v, c1v, s0v, s1v;
                if (rope) { const float* rp = ROPE + (size_t)row * 16; c0v = *(const f32x4*)rp; c1v = *(const f32x4*)(rp + 4); s0v = *(const f32x4*)(rp + 8); s1v = *(const f32x4*)(rp + 12);
                    if (fq == 1) { s0v = -s0v; s1v = -s1v; } }
#pragma unroll
                for (int bj = 0; bj < 2; ++bj) { f32x4 v0 = acc[ai][bj][m][0], v1 = acc[ai][bj][m][1];
                    if (isg) {
#pragma unroll
                        for (int j = 0; j < 4; ++j) { v0[j] = sigmoid_f(v0[j]); v1[j] = sigmoid_f(v1[j]); }
                    } else if (rope) {
                        f32x4 p0, p1;
#pragma unroll
                        for (int j = 0; j < 4; ++j) { p0[j] = __shfl_xor(v0[j], 16); p1[j] = __shfl_xor(v1[j], 16); }
                        if (fq < 2) { v0 = v0 * c0v - p0 * s0v; v1 = v1 * c1v - p1 * s1v; }
                    }
                    v0 = v0 * sc; v1 = v1 * sc;
                    st8(rowp + bj * 128, v0, v1); } }
    }
};
struct EpiSsmOut {
    static constexpr bool PERM = true;
    bf16_t* MIXIN; const bf16_t* GATES;
    DI void operator()(AccRef acc, const Unit& u, int wr, int wc, int fr, int fq) const {
        const int row0 = u.pm * 256 + wr * 64 + fr, col0 = u.pn * 256 + wc * 32 + 8 * fq;
#pragma unroll
        for (int ai = 0; ai < 2; ++ai)
#pragma unroll
            for (int m = 0; m < 4; ++m) { const int row = row0 + ai * 128 + m * 16;
#pragma unroll
                for (int bj = 0; bj < 2; ++bj) { const u32x4 gw = *(const u32x4*)(GATES + (size_t)row * DIN + col0 + bj * 128);
                    f32x4 v0 = acc[ai][bj][m][0], v1 = acc[ai][bj][m][1];
                    v0[0] *= bflo(gw.x); v0[1] *= bfhi(gw.x); v0[2] *= bflo(gw.y); v0[3] *= bfhi(gw.y); v1[0] *= bflo(gw.z); v1[1] *= bfhi(gw.z); v1[2] *= bflo(gw.w); v1[3] *= bfhi(gw.w);
                    st8(MIXIN + (size_t)row * DM + col0 + bj * 128, v0, v1); } }
    }
};
struct EpiAttOut {
    static constexpr bool PERM = true;
    bf16_t* MIXIN; const bf16_t* GATES;
    DI void operator()(AccRef acc, const Unit& u, int wr, int wc, int fr, int fq) const {
        const int row0 = u.pm * 256 + wr * 64 + fr, col0 = u.pn * 256 + wc * 32 + 8 * fq;
#pragma unroll
        for (int ai = 0; ai < 2; ++ai)
#pragma unroll
            for (int m = 0; m < 4; ++m) { const int row = row0 + ai * 128 + m * 16;
#pragma unroll
                for (int bj = 0; bj < 2; ++bj) { const u32x4 gw = *(const u32x4*)(GATES + (size_t)row * DIN + DM + col0 + bj * 128);
                    bf16_t* mp = MIXIN + (size_t)row * DM + col0 + bj * 128; const u32x4 pw = *(const u32x4*)mp;
                    f32x4 v0 = acc[ai][bj][m][0], v1 = acc[ai][bj][m][1];
                    v0[0] = v0[0] * bflo(gw.x) + bflo(pw.x); v0[1] = v0[1] * bfhi(gw.x) + bfhi(pw.x); v0[2] = v0[2] * bflo(gw.y) + bflo(pw.y); v0[3] = v0[3] * bfhi(gw.y) + bfhi(pw.y);
                    v1[0] = v1[0] * bflo(gw.z) + bflo(pw.z); v1[1] = v1[1] * bfhi(gw.z) + bfhi(pw.z); v1[2] = v1[2] * bflo(gw.w) + bflo(pw.w); v1[3] = v1[3] * bfhi(gw.w) + bfhi(pw.w);
                    st8(mp, v0, v1); } }
    }
};
struct EpiF32 {
    static constexpr bool PERM = false;
    float* O;
    DI void operator()(AccRef acc, const Unit& u, int wr, int wc, int fr, int fq) const {
        const int row0 = u.pm * 256 + wr * 64 + fr, col0 = u.pn * 256 + wc * 32 + 4 * fq;
#pragma unroll
        for (int ai = 0; ai < 2; ++ai)
#pragma unroll
            for (int m = 0; m < 4; ++m) { float* rowp = O + (size_t)(row0 + ai * 128 + m * 16) * DM + col0;
#pragma unroll
                for (int bj = 0; bj < 2; ++bj)
#pragma unroll
                    for (int n = 0; n < 2; ++n) *(f32x4*)(rowp + bj * 128 + n * 16) = acc[ai][bj][m][n]; }
    }
};
struct EpiSwiglu {
    static constexpr bool PERM = true;
    bf16_t* HID;
    DI void operator()(AccRef acc, const Unit& u, int wr, int wc, int fr, int fq) const {
        const int row0 = u.pm * 256 + wr * 64 + fr, col0 = u.pn * 128 + wc * 32 + 8 * fq;
#pragma unroll
        for (int ai = 0; ai < 2; ++ai)
#pragma unroll
            for (int m = 0; m < 4; ++m) { f32x4 v0, v1;
#pragma unroll
                for (int j = 0; j < 4; ++j) { v0[j] = silu_f(acc[ai][0][m][0][j]) * acc[ai][1][m][0][j]; v1[j] = silu_f(acc[ai][0][m][1][j]) * acc[ai][1][m][1][j]; }
                st8(HID + (size_t)(row0 + ai * 128 + m * 16) * FFH + col0, v0, v1); }
    }
};

DI float wave_sum(float v) {
#pragma unroll
    for (int o = 1; o < 64; o <<= 1) v += __shfl_xor(v, o);
    return v;
}
DI void transpose_item(const float* W, int ldw, int src_n0, int k0, bf16_t* WT, int ldt, int dst_row0, const float* kscale, LAS float* scr, int lane) {
#pragma unroll 8
    for (int i = 0; i < 32; ++i) { const int kk = 2 * i + (lane >> 5); float v = W[(size_t)(k0 + kk) * ldw + src_n0 + (lane & 31)]; if (kscale) v *= kscale[k0 + kk]; scr[kk * 33 + (lane & 31)] = v; }
    asm volatile("s_waitcnt lgkmcnt(0)" ::: "memory");
    const int c = lane & 7;
#pragma unroll
    for (int j = 0; j < 4; ++j) { const int n = (lane >> 3) + 8 * j; const LAS float* s = scr + (8 * c) * 33 + n;
        u32x4 o; o.x = cvtpk(s[0 * 33], s[1 * 33]); o.y = cvtpk(s[2 * 33], s[3 * 33]); o.z = cvtpk(s[4 * 33], s[5 * 33]); o.w = cvtpk(s[6 * 33], s[7 * 33]);
        *(u32x4*)(WT + (size_t)(dst_row0 + n) * ldt + k0 + 8 * c) = o; }
    asm volatile("s_waitcnt lgkmcnt(0)" ::: "memory");
}
DI void rms_row_to_bf16(const float* xrow, const float* w, bf16_t* orow, int lane) {
    const f32x4* xr = (const f32x4*)xrow + lane; const f32x4* wr_ = (const f32x4*)w + lane;
    f32x4 v[4]; float s = 0.f;
#pragma unroll
    for (int j = 0; j < 4; ++j) { v[j] = xr[64 * j]; s += (v[j].x * v[j].x + v[j].y * v[j].y) + (v[j].z * v[j].z + v[j].w * v[j].w); }
    const float rstd = rsqrtf(wave_sum(s) * (1.f / DM) + EPS);
    u32x2* o8 = (u32x2*)orow + lane;
#pragma unroll
    for (int j = 0; j < 4; ++j) { const f32x4 g = wr_[64 * j]; u32x2 o; o.x = cvtpk(v[j].x * rstd * g.x, v[j].y * rstd * g.y); o.y = cvtpk(v[j].z * rstd * g.z, v[j].w * rstd * g.w); o8[64 * j] = o; }
}

DI void p0_prologue(const Params& P, LAS unsigned char* lds, int G) {
    const int tid = otid(), lane = tid & 63, wave = tid >> 6;
    LAS float* scr = (LAS float*)(lds + wave * 16384);
    const int gw = blockIdx.x * 8 + wave, NGW = G * 8;
    unsigned char* ws = P.ws;
    bf16_t* Win = (bf16_t*)(ws + WS_WIN); bf16_t* Wssm = (bf16_t*)(ws + WS_WSSM); bf16_t* Watt = (bf16_t*)(ws + WS_WATT); bf16_t* Wmix = (bf16_t*)(ws + WS_WMIX);
    bf16_t* Wgu = (bf16_t*)(ws + WS_WGU); bf16_t* Wdn = (bf16_t*)(ws + WS_WDN);
    constexpr int INC = 10272;
    constexpr int I_IN = 16 * 320, I_DT = 16, I_SSM = 32 * 32, I_ATT = 16 * 32, I_MIX = 16 * 32, I_G = 16 * 88, I_U = 16 * 88, I_D = 44 * 32;
    constexpr int NIT = I_IN + I_DT + I_SSM + I_ATT + I_MIX + I_G + I_U + I_D;
    for (int it = gw; it < NIT; it += NGW) {
        int r = it;
        if (r < I_IN) { const int kb = r / 320, nb = r % 320; const int n0 = nb * 32;
            const int src = n0 < 5120 ? n0 : n0 + 32; const int dst = n0 < 5120 ? n0 : n0 + 256;
            transpose_item(P.w_in, INC, src, kb * 64, Win, DM, dst, nullptr, scr, lane); continue; } r -= I_IN;
        if (r < I_DT) { transpose_item(P.w_in, INC, 5120, r * 64, Win, DM, 5120, nullptr, scr, lane); continue; } r -= I_DT;
        if (r < I_SSM) { const int kb = r / 32, nb = r % 32; transpose_item(P.w_ssm_out, DM, nb * 32, kb * 64, Wssm, DIN, nb * 32, P.ssm_norm_w, scr, lane); continue; } r -= I_SSM;
        if (r < I_ATT) { const int kb = r / 32, nb = r % 32; transpose_item(P.w_attn_out, DM, nb * 32, kb * 64, Watt, DM, nb * 32, nullptr, scr, lane); continue; } r -= I_ATT;
        if (r < I_MIX) { const int kb = r / 32, nb = r % 32; transpose_item(P.w_mix, DM, nb * 32, kb * 64, Wmix, DM, nb * 32, nullptr, scr, lane); continue; } r -= I_MIX;
        if (r < I_G) { const int kb = r / 88, nb = r % 88; const int n0 = nb * 32; transpose_item(P.w_gate, FFH, n0, kb * 64, Wgu, DM, 256 * (n0 >> 7) + (n0 & 127), nullptr, scr, lane); continue; } r -= I_G;
        if (r < I_U) { const int kb = r / 88, nb = r % 88; const int n0 = nb * 32; transpose_item(P.w_up, FFH, n0, kb * 64, Wgu, DM, 256 * (n0 >> 7) + 128 + (n0 & 127), nullptr, scr, lane); continue; } r -= I_U;
        { const int kb = r / 32, nb = r % 32; transpose_item(P.w_down, DM, nb * 32, kb * 64, Wdn, FFH, nb * 32, nullptr, scr, lane); }
    }
    bf16_t* XN = (bf16_t*)(ws + WS_XN);
    for (int m = gw; m < T_TOK; m += NGW) rms_row_to_bf16(P.x + (size_t)m * DM, P.n_pre_mix, XN + (size_t)m * DM, lane);
    float* ROPE = (float*)(ws + WS_ROPE);
    for (int e = blockIdx.x * 512 + tid; e < T_TOK * 8; e += G * 512) {
        const int t = e >> 3, i = e & 7;
        const float invf = i == 0 ? 1.0f : i == 1 ? 0.1939227432012558f : i == 2 ? 0.03760603070259094f : i == 3 ? 0.007292664609849453f : i == 4 ? 0.0014142135623842478f
                          : i == 5 ? 0.00027424818836152554f : i == 6 ? 5.318296098266728e-05f : 1.0313386155758053e-05f;
        const float ang = (float)P.pos[t] * invf;
        const double a = (double)ang; const double k = rint(a * 0.15915494309189535); const double rr = a - k * 6.283185307179586;
        const float rf = (float)rr;
        ROPE[t * 16 + i] = __cosf(rf); ROPE[t * 16 + 8 + i] = __sinf(rf);
    }
}

DI s16x4 trrd(const LAS unsigned char* p) { return __builtin_bit_cast(s16x4, __builtin_amdgcn_ds_read_tr16_b64_v4i16((LAS s16x4*)p)); }
DI bf16x8 cat8(s16x4 lo, s16x4 hi) { return __builtin_shufflevector(lo, hi, 0, 1, 2, 3, 4, 5, 6, 7); }
#define MFMA32(a, b, c) __builtin_amdgcn_mfma_f32_32x32x16_bf16((a), (b), (c), 0, 0, 0)
DI int crow(int i, int hi) { return (i & 3) + 8 * (i >> 2) + 4 * hi; }

constexpr int SS_BC = 272, SS_X = 144;
constexpr int L_CS = 0, L_BS = L_CS + 128 * SS_BC, L_HS = L_BS + 128 * SS_BC, L_XS = L_HS + 64 * SS_BC, L_XW = L_XS + 128 * SS_X, L_DT = L_XW + 128 * SS_X, L_DA = L_DT + 512, L_ACS = L_DA + 512, L_SSD_END = L_ACS + 512;
static_assert(L_SSD_END <= 131072, "ssd lds");

template <int R> DI void conv_rows(const bf16_t* XBC, int t0, int r0, bool first, int col, const float* conv_w, const float* conv_b, float (&outv)[R][8]) {
    u32x4 in[R + 3];
#pragma unroll
    for (int i = 0; i < R + 3; ++i) { const int rr = r0 - 3 + i; if (first && rr < 0) in[i] = (u32x4){0u, 0u, 0u, 0u}; else in[i] = *(const u32x4*)(XBC + (size_t)(t0 + rr) * XBCW + col); }
    float w[4][8], bsv[8];
#pragma unroll
    for (int j = 0; j < 4; ++j) { const f32x4 a = *(const f32x4*)(conv_w + j * XBCW + col), b = *(const f32x4*)(conv_w + j * XBCW + col + 4);
        w[j][0] = a.x; w[j][1] = a.y; w[j][2] = a.z; w[j][3] = a.w; w[j][4] = b.x; w[j][5] = b.y; w[j][6] = b.z; w[j][7] = b.w; }
    { const f32x4 a = *(const f32x4*)(conv_b + col), b = *(const f32x4*)(conv_b + col + 4); bsv[0] = a.x; bsv[1] = a.y; bsv[2] = a.z; bsv[3] = a.w; bsv[4] = b.x; bsv[5] = b.y; bsv[6] = b.z; bsv[7] = b.w; }
#pragma unroll
    for (int r = 0; r < R; ++r) {
#pragma unroll
        for (int c = 0; c < 8; ++c) outv[r][c] = bsv[c];
#pragma unroll
        for (int j = 0; j < 4; ++j) { const u32x4 v = in[r + j];
            outv[r][0] += w[j][0] * bflo(v.x); outv[r][1] += w[j][1] * bfhi(v.x); outv[r][2] += w[j][2] * bflo(v.y); outv[r][3] += w[j][3] * bfhi(v.y);
            outv[r][4] += w[j][4] * bflo(v.z); outv[r][5] += w[j][5] * bfhi(v.z); outv[r][6] += w[j][6] * bflo(v.w); outv[r][7] += w[j][7] * bfhi(v.w); }
#pragma unroll
        for (int c = 0; c < 8; ++c) outv[r][c] = silu_f(outv[r][c]);
    }
}

DI void ssd_unit(const Params& P, LAS unsigned char* lds, int b, int h, bool dostore = true) {
    const int tid = otid(), lane = tid & 63, wid = __builtin_amdgcn_readfirstlane(tid >> 6), r32 = lane & 31, hi = lane >> 5;
    const int q4 = (lane & 15) >> 2, p4 = lane & 3, g1 = (lane >> 4) & 1;
    const int g = h >> 3;
    bf16_t* ZY = (bf16_t*)(P.ws + WS_ZY); const bf16_t* XBC = (const bf16_t*)(P.ws + WS_R96); const float* DT = (const float*)(P.ws + WS_DT);
    const float Ah = -__expf(P.a_log[h]), Dh = P.d_skip[h];
    LAS float* sm_dt = (LAS float*)(lds + L_DT); LAS float* sm_da = (LAS float*)(lds + L_DA); LAS float* sm_acs = (LAS float*)(lds + L_ACS);
    const int pb = wid & 1, lb = wid >> 1;
    f32x16 hacc;
#pragma unroll
    for (int i = 0; i < 16; ++i) hacc[i] = 0.f;
    for (int c = 0; c < 16; ++c) {
        const int t0 = b * SEQ + c * 128; const bool first = (c == 0);
        if (tid < 128) { const float dtv = DT[(size_t)(t0 + tid) * NHS + h]; sm_dt[tid] = dtv; sm_da[tid] = dtv * Ah; }
        __syncthreads();
        if (tid < 128) { float s = 0.f; for (int i = 0; i <= tid; ++i) s += sm_da[i]; sm_acs[tid] = s; }
        __syncthreads();
        const float a_end = sm_acs[127];
        { const int cgp = tid & 31, rs = tid >> 5; const bool isB = cgp < 16; const int col = DIN + (isB ? 0 : 512) + g * 128 + (cgp & 15) * 8; const int r0 = rs * 8;
            float ov[8][8]; conv_rows<8>(XBC, t0, r0, first, col, P.conv_w, P.conv_b, ov);
            LAS unsigned char* dst = lds + (isB ? L_BS : L_CS) + (cgp & 15) * 16;
#pragma unroll
            for (int r = 0; r < 8; ++r) { u32x4 w; w.x = cvtpk(ov[r][0], ov[r][1]); w.y = cvtpk(ov[r][2], ov[r][3]); w.z = cvtpk(ov[r][4], ov[r][5]); w.w = cvtpk(ov[r][6], ov[r][7]);
                *(LAS u32x4*)(dst + (r0 + r) * SS_BC) = w; } }
        { const int cgx = tid & 7, rs = tid >> 3; const int col = h * 64 + cgx * 8; const int r0 = rs * 2;
            float ov[2][8]; conv_rows<2>(XBC, t0, r0, first, col, P.conv_w, P.conv_b, ov);
#pragma unroll
            for (int r = 0; r < 2; ++r) { const int l = r0 + r; const float wl = sm_dt[l] * __expf(a_end - sm_acs[l]);
                u32x4 w; w.x = cvtpk(ov[r][0], ov[r][1]); w.y = cvtpk(ov[r][2], ov[r][3]); w.z = cvtpk(ov[r][4], ov[r][5]); w.w = cvtpk(ov[r][6], ov[r][7]);
                *(LAS u32x4*)(lds + L_XS + l * SS_X + cgx * 16) = w;
                w.x = cvtpk(ov[r][0] * wl, ov[r][1] * wl); w.y = cvtpk(ov[r][2] * wl, ov[r][3] * wl); w.z = cvtpk(ov[r][4] * wl, ov[r][5] * wl); w.w = cvtpk(ov[r][6] * wl, ov[r][7] * wl);
                *(LAS u32x4*)(lds + L_XW + l * SS_X + cgx * 16) = w; } }
        {
#pragma unroll
            for (int i = 0; i < 16; ++i) { const int p = 32 * pb + crow(i, hi), n = 32 * lb + r32; *(LAS bf16_t*)(lds + L_HS + p * SS_BC + n * 2) = (bf16_t)(cvtpk(hacc[i], 0.f) & 0xffffu); } }
        __syncthreads();
        bf16x8 cf[8];
#pragma unroll
        for (int ks = 0; ks < 8; ++ks) cf[ks] = *(const LAS bf16x8*)(lds + L_CS + (32 * lb + r32) * SS_BC + (16 * ks + 8 * hi) * 2);
        f32x16 acc;
#pragma unroll
        for (int i = 0; i < 16; ++i) acc[i] = 0.f;
#pragma unroll
        for (int ks = 0; ks < 8; ++ks) { const bf16x8 a = *(const LAS bf16x8*)(lds + L_HS + (32 * pb + r32) * SS_BC + (16 * ks + 8 * hi) * 2); acc = MFMA32(a, cf[ks], acc); }
        const float acs_l = sm_acs[32 * lb + r32];
        { const float ea = __expf(acs_l);
#pragma unroll
          for (int i = 0; i < 16; ++i) acc[i] *= ea; }
        for (int sb = 0; sb <= lb; ++sb) {
            f32x16 st;
#pragma unroll
            for (int i = 0; i < 16; ++i) st[i] = 0.f;
#pragma unroll
            for (int ks = 0; ks < 8; ++ks) { const bf16x8 a = *(const LAS bf16x8*)(lds + L_BS + (32 * sb + r32) * SS_BC + (16 * ks + 8 * hi) * 2); st = MFMA32(a, cf[ks], st); }
            const int l = 32 * lb + r32;
#pragma unroll
            for (int i = 0; i < 16; ++i) { const int s = 32 * sb + crow(i, hi); float v = st[i] * __expf(acs_l - sm_acs[s]) * sm_dt[s]; v = (s <= l) ? v : 0.f; if (s == l) v += Dh; st[i] = v; }
#pragma unroll
            for (int k2 = 0; k2 < 2; ++k2) {
                u32x4 mw; mw.x = cvtpk(st[8 * k2 + 0], st[8 * k2 + 1]); mw.y = cvtpk(st[8 * k2 + 2], st[8 * k2 + 3]); mw.z = cvtpk(st[8 * k2 + 4], st[8 * k2 + 5]); mw.w = cvtpk(st[8 * k2 + 6], st[8 * k2 + 7]);
                const LAS unsigned char* xp = lds + L_XS + (32 * sb + 16 * k2 + 4 * hi + q4) * SS_X + (32 * pb + 16 * g1) * 2 + 8 * p4;
                const bf16x8 a = cat8(trrd(xp), trrd(xp + 8 * SS_X));
                acc = MFMA32(a, __builtin_bit_cast(bf16x8, mw), acc);
            }
        }
        {
            const size_t trow = (size_t)(t0 + 32 * lb + r32) * DIN + h * 64 + 32 * pb + 4 * hi;
#pragma unroll
            for (int g4 = 0; g4 < 4; ++g4) { bf16_t* zp = ZY + trow + 8 * g4; const u32x2 zw = *(const u32x2*)zp;
                u32x2 o; o.x = cvtpk(acc[4 * g4 + 0] * bflo(zw.x), acc[4 * g4 + 1] * bfhi(zw.x)); o.y = cvtpk(acc[4 * g4 + 2] * bflo(zw.y), acc[4 * g4 + 3] * bfhi(zw.y));
                if (dostore) *(u32x2*)zp = o; }
        }
        { const float ee = __expf(a_end);
#pragma unroll
          for (int i = 0; i < 16; ++i) hacc[i] *= ee; }
#pragma unroll
        for (int ks = 0; ks < 8; ++ks) {
            const LAS unsigned char* xp = lds + L_XW + (16 * ks + 8 * hi + q4) * SS_X + (32 * pb + 16 * g1) * 2 + 8 * p4;
            const LAS unsigned char* bp = lds + L_BS + (16 * ks + 8 * hi + q4) * SS_BC + (32 * lb + 16 * g1) * 2 + 8 * p4;
            const bf16x8 a = cat8(trrd(xp), trrd(xp + 4 * SS_X));
            const bf16x8 bb = cat8(trrd(bp), trrd(bp + 4 * SS_BC));
            hacc = MFMA32(a, bb, hacc);
        }
        __syncthreads();
    }
}

constexpr int AT_KS = 144, AT_VS = 288;
constexpr int LA_K = 0, LA_V = LA_K + 2 * 64 * AT_KS, LA_ST = LA_V + 2 * 64 * AT_VS, LA_END = LA_ST + 8 * 32 * 64 * 4;
static_assert(LA_END <= 131072 - 64, "attn lds");

DI void attn_unit(const Params& P, LAS unsigned char* lds, int b, int hh, int qb, float lam, bool dostore = true) {
    const int tid = otid(), lane = tid & 63, wid = __builtin_amdgcn_readfirstlane(tid >> 6), r32 = lane & 31, hi = lane >> 5;
    const int q4 = (lane & 15) >> 2, p4 = lane & 3, g1 = (lane >> 4) & 1;
    bf16_t* QKV = (bf16_t*)(P.ws + WS_R96);
    const size_t rowbase = (size_t)b * SEQ; const int q0 = qb * 256;
    const int qmin_w = q0 + wid * 32;
    const int ntile = (q0 + 256) / 64;
    LAS unsigned* stash = (LAS unsigned*)(lds + LA_ST) + wid * 2048 + lane;
    const int krow_ = tid >> 3, kch = tid & 7, vrow = tid >> 4, vch = tid & 15;
    for (int sub = 0; sub < 2; ++sub) {
        const bf16_t* Kg = QKV + rowbase * XBCW + DM + hh * 128 + sub * 64 + kch * 8;
        const bf16_t* Vg = QKV + rowbase * XBCW + 2 * DM + hh * 128 + vch * 8;
        bf16x8 qf[4];
        { const bf16_t* Qg = QKV + (rowbase + qmin_w + r32) * XBCW + hh * 128 + sub * 64 + hi * 8;
#pragma unroll
          for (int d0 = 0; d0 < 4; ++d0) qf[d0] = *(const bf16x8*)(Qg + d0 * 16); }
        float mrun = -1e30f, lrun = 0.f;
        f32x16 o[4];
#pragma unroll
        for (int e = 0; e < 4; ++e)
#pragma unroll
            for (int i = 0; i < 16; ++i) o[e][i] = 0.f;
        u32x4 kreg, vreg0, vreg1;
        kreg = *(const u32x4*)(Kg + (size_t)krow_ * XBCW); vreg0 = *(const u32x4*)(Vg + (size_t)vrow * XBCW); vreg1 = *(const u32x4*)(Vg + (size_t)(vrow + 32) * XBCW);
        for (int j = 0; j < ntile; ++j) {
            LAS unsigned char* Ks = lds + LA_K + (j & 1) * 64 * AT_KS; LAS unsigned char* Vs = lds + LA_V + (j & 1) * 64 * AT_VS;
            *(LAS u32x4*)(Ks + krow_ * AT_KS + kch * 16) = kreg;
            *(LAS u32x4*)(Vs + vrow * AT_VS + vch * 16) = vreg0; *(LAS u32x4*)(Vs + (vrow + 32) * AT_VS + vch * 16) = vreg1;
            __syncthreads();
            if (j + 1 < ntile) { const size_t ro = (size_t)(j + 1) * 64;
                kreg = *(const u32x4*)(Kg + (ro + krow_) * XBCW); vreg0 = *(const u32x4*)(Vg + (ro + vrow) * XBCW); vreg1 = *(const u32x4*)(Vg + (ro + vrow + 32) * XBCW); }
            if (64 * j <= qmin_w + 31) {
                f32x16 s0, s1;
#pragma unroll
                for (int i = 0; i < 16; ++i) { s0[i] = 0.f; s1[i] = 0.f; }
#pragma unroll
                for (int d0 = 0; d0 < 4; ++d0) {
                    const bf16x8 a0 = *(const LAS bf16x8*)(Ks + r32 * AT_KS + (d0 * 16 + hi * 8) * 2);
                    const bf16x8 a1 = *(const LAS bf16x8*)(Ks + (32 + r32) * AT_KS + (d0 * 16 + hi * 8) * 2);
                    s0 = MFMA32(a0, qf[d0], s0); s1 = MFMA32(a1, qf[d0], s1);
                }
                if (64 * j + 63 > qmin_w) {
                    const int qg = qmin_w + r32;
#pragma unroll
                    for (int i = 0; i < 16; ++i) { const int kv = 64 * j + crow(i, hi); if (kv > qg) s0[i] = -INFINITY; if (kv + 32 > qg) s1[i] = -INFINITY; }
                }
                float mx = s0[0];
#pragma unroll
                for (int i = 1; i < 16; ++i) mx = fmaxf(mx, s0[i]);
#pragma unroll
                for (int i = 0; i < 16; ++i) mx = fmaxf(mx, s1[i]);
                mx = fmaxf(mx, __shfl_xor(mx, 32));
                const float mnew = fmaxf(mrun, mx); const float alpha = exp2f(mrun - mnew); mrun = mnew;
                float rs = 0.f;
#pragma unroll
                for (int i = 0; i < 16; ++i) { s0[i] = exp2f(s0[i] - mnew); s1[i] = exp2f(s1[i] - mnew); rs += s0[i] + s1[i]; }
                lrun = lrun * alpha + rs;
#pragma unroll
                for (int e = 0; e < 4; ++e)
#pragma unroll
                    for (int i = 0; i < 16; ++i) o[e][i] *= alpha;
                bf16x8 pf[2][2];
#pragma unroll
                for (int k2 = 0; k2 < 2; ++k2) {
                    u32x4 w; w.x = cvtpk(s0[8 * k2 + 0], s0[8 * k2 + 1]); w.y = cvtpk(s0[8 * k2 + 2], s0[8 * k2 + 3]); w.z = cvtpk(s0[8 * k2 + 4], s0[8 * k2 + 5]); w.w = cvtpk(s0[8 * k2 + 6], s0[8 * k2 + 7]);
                    pf[0][k2] = __builtin_bit_cast(bf16x8, w);
                    w.x = cvtpk(s1[8 * k2 + 0], s1[8 * k2 + 1]); w.y = cvtpk(s1[8 * k2 + 2], s1[8 * k2 + 3]); w.z = cvtpk(s1[8 * k2 + 4], s1[8 * k2 + 5]); w.w = cvtpk(s1[8 * k2 + 6], s1[8 * k2 + 7]);
                    pf[1][k2] = __builtin_bit_cast(bf16x8, w);
                }
#pragma unroll
                for (int e = 0; e < 4; ++e)
#pragma unroll
                    for (int blk = 0; blk < 2; ++blk)
#pragma unroll
                        for (int k2 = 0; k2 < 2; ++k2) {
                            const LAS unsigned char* vp = Vs + (32 * blk + 16 * k2 + 4 * hi + q4) * AT_VS + (32 * e + 16 * g1) * 2 + 8 * p4;
                            const bf16x8 a = cat8(trrd(vp), trrd(vp + 8 * AT_VS));
                            o[e] = MFMA32(a, pf[blk][k2], o[e]);
                            if (k2 == 1) __builtin_amdgcn_sched_barrier(0);
                        }
            }
        }
        const float ltot = lrun + __shfl_xor(lrun, 32); const float inv = 1.f / ltot;
        if (sub == 0) {
#pragma unroll
            for (int e = 0; e < 4; ++e)
#pragma unroll
                for (int k = 0; k < 8; ++k) stash[(e * 8 + k) * 64] = cvtpk(o[e][2 * k] * inv, o[e][2 * k + 1] * inv);
        } else {
            float ss = 0.f;
#pragma unroll
            for (int e = 0; e < 4; ++e)
#pragma unroll
                for (int k = 0; k < 8; ++k) { const unsigned w = stash[(e * 8 + k) * 64];
                    const float v0 = bflo(w) - lam * (o[e][2 * k] * inv), v1 = bfhi(w) - lam * (o[e][2 * k + 1] * inv);
                    o[e][2 * k] = v0; o[e][2 * k + 1] = v1; ss += v0 * v0 + v1 * v1; }
            ss += __shfl_xor(ss, 32);
            const float rstd = rsqrtf(ss * (1.f / 128.f) + EPS) * (1.f - LAM_INIT);
            bf16_t* Og = QKV + (rowbase + qmin_w + r32) * XBCW + hh * 128 + 4 * hi;
#pragma unroll
            for (int e = 0; e < 4; ++e)
#pragma unroll
                for (int g4 = 0; g4 < 4; ++g4) { const int ec = 32 * e + 8 * g4 + 4 * hi; const f32x4 sw = *(const f32x4*)(P.subln_w + ec);
                    u32x2 w; w.x = cvtpk(o[e][4 * g4 + 0] * rstd * sw.x, o[e][4 * g4 + 1] * rstd * sw.y); w.y = cvtpk(o[e][4 * g4 + 2] * rstd * sw.z, o[e][4 * g4 + 3] * rstd * sw.w);
                    if (dostore) *(u32x2*)(Og + 32 * e + 8 * g4) = w; }
        }
        __syncthreads();
    }
}

DI void ynorm_row(bf16_t* yrow, int lane) {
    u32x4* p = (u32x4*)yrow + lane * 4; u32x4 v[4]; float ss = 0.f;
#pragma unroll
    for (int j = 0; j < 4; ++j) { v[j] = p[j];
        const float a0 = bflo(v[j].x), a1 = bfhi(v[j].x), a2 = bflo(v[j].y), a3 = bfhi(v[j].y), a4 = bflo(v[j].z), a5 = bfhi(v[j].z), a6 = bflo(v[j].w), a7 = bfhi(v[j].w);
        ss += (a0 * a0 + a1 * a1) + (a2 * a2 + a3 * a3) + (a4 * a4 + a5 * a5) + (a6 * a6 + a7 * a7); }
    ss += __shfl_xor(ss, 1); ss += __shfl_xor(ss, 2); ss += __shfl_xor(ss, 4); ss += __shfl_xor(ss, 8);
    const float r = rsqrtf(ss * (1.f / 512.f) + EPS);
#pragma unroll
    for (int j = 0; j < 4; ++j) { u32x4 o;
        o.x = cvtpk(bflo(v[j].x) * r, bfhi(v[j].x) * r); o.y = cvtpk(bflo(v[j].y) * r, bfhi(v[j].y) * r); o.z = cvtpk(bflo(v[j].z) * r, bfhi(v[j].z) * r); o.w = cvtpk(bflo(v[j].w) * r, bfhi(v[j].w) * r);
        p[j] = o; }
}

DI void row_pass5(const float* mixed, const float* x, const float* w1, const float* w2, float* out, bf16_t* h2, int lane) {
    const f32x4* mr = (const f32x4*)mixed + lane; const f32x4* xr = (const f32x4*)x + lane;
    f32x4 v[4]; float s = 0.f;
#pragma unroll
    for (int j = 0; j < 4; ++j) { v[j] = mr[64 * j]; s += (v[j].x * v[j].x + v[j].y * v[j].y) + (v[j].z * v[j].z + v[j].w * v[j].w); }
    const float rstd = rsqrtf(wave_sum(s) * (1.f / DM) + EPS);
    float s2 = 0.f;
#pragma unroll
    for (int j = 0; j < 4; ++j) { const f32x4 g = ((const f32x4*)w1 + lane)[64 * j]; v[j] = xr[64 * j] + v[j] * rstd * g; ((f32x4*)out + lane)[64 * j] = v[j];
        s2 += (v[j].x * v[j].x + v[j].y * v[j].y) + (v[j].z * v[j].z + v[j].w * v[j].w); }
    const float rstd2 = rsqrtf(wave_sum(s2) * (1.f / DM) + EPS);
    u32x2* o8 = (u32x2*)h2 + lane;
#pragma unroll
    for (int j = 0; j < 4; ++j) { const f32x4 g = ((const f32x4*)w2 + lane)[64 * j]; u32x2 o; o.x = cvtpk(v[j].x * rstd2 * g.x, v[j].y * rstd2 * g.y); o.y = cvtpk(v[j].z * rstd2 * g.z, v[j].w * rstd2 * g.w); o8[64 * j] = o; }
}
DI void row_pass8(const float* f, const float* w, float* out, int lane) {
    const f32x4* fr_ = (const f32x4*)f + lane;
    f32x4 v[4]; float s = 0.f;
#pragma unroll
    for (int j = 0; j < 4; ++j) { v[j] = fr_[64 * j]; s += (v[j].x * v[j].x + v[j].y * v[j].y) + (v[j].z * v[j].z + v[j].w * v[j].w); }
    const float rstd = rsqrtf(wave_sum(s) * (1.f / DM) + EPS);
#pragma unroll
    for (int j = 0; j < 4; ++j) { const f32x4 g = ((const f32x4*)w + lane)[64 * j]; f32x4* op = (f32x4*)out + lane + 64 * j; *op = *op + v[j] * rstd * g; }
}


#define XB_TMO      128
#define XB_XCNT(j)  (256  + 64 * (j))
#define XB_XSUB(j)  (1280 + 64 * (j))
#define XB_XGEN(j)  (2304 + 64 * (j))
#define XB_TOP      3328
#define XB_TOPGEN   3392
#define XCD_BAR_WORDS 3456
#define XB_SPIN_CAP (1u << 22)
DI unsigned xb_ld(unsigned* p)              { return __hip_atomic_load(p, __ATOMIC_RELAXED, __HIP_MEMORY_SCOPE_AGENT); }
DI unsigned xb_add(unsigned* p, unsigned v) { return __hip_atomic_fetch_add(p, v, __ATOMIC_RELAXED, __HIP_MEMORY_SCOPE_AGENT); }
DI unsigned xb_xcc_id() { return (unsigned)__builtin_amdgcn_s_getreg((3 << 11) | 20) & 0xFu; }
#define XB_SPIN(cond, bar) do { unsigned _sp = 0; while (cond) { __builtin_amdgcn_s_sleep(1); \
    if ((++_sp & 255u) == 0u) { if (xb_ld(&(bar)[XB_TMO])) break; if (_sp > XB_SPIN_CAP) { atomicAdd(&(bar)[XB_TMO], 1u); break; } } } } while (0)
struct XcdBarrier { unsigned* bar; unsigned x; volatile LAS unsigned* st; };
DI XcdBarrier xcd_barrier_post(unsigned* bar, volatile LAS unsigned* st) {
    XcdBarrier b; b.bar = bar; b.x = xb_xcc_id(); b.st = st;
    if (threadIdx.x == 0) (void)xb_add(&bar[XB_XCNT(b.x)], 1u);
    return b;
}
DI void xcd_barrier_complete(unsigned* bar, unsigned x, unsigned& nloc, unsigned& nx) {
    const unsigned G = gridDim.x * gridDim.y * gridDim.z;
    unsigned sum, cnt, mine, sp = 0u;
    for (;;) {
        sum = 0u; cnt = 0u; mine = 0u;
#pragma unroll
        for (unsigned j = 0; j < 16; ++j) { const unsigned c = xb_ld(&bar[XB_XCNT(j)]); sum += c; cnt += (c > 0u) ? 1u : 0u; mine = (j == x) ? c : mine; }
        if (sum == G) break;
        __builtin_amdgcn_s_sleep(1);
        if ((++sp & 255u) == 0u) { if (xb_ld(&bar[XB_TMO])) break; if (sp > XB_SPIN_CAP) { atomicAdd(&bar[XB_TMO], 1u); break; } }
    }
    nloc = mine > 0u ? mine : 1u; nx = cnt > 0u ? cnt : 1u;
}
DI void xcd_barrier(const XcdBarrier& b) {
    asm volatile("s_waitcnt vmcnt(0)" ::: "memory");
    __syncthreads();
    if (threadIdx.x == 0) {
        unsigned* bar = b.bar;
        __builtin_amdgcn_s_waitcnt(0);
        unsigned nloc = b.st[0], nx = b.st[1];
        if (nloc == 0u) { xcd_barrier_complete(bar, b.x, nloc, nx); b.st[0] = nloc; b.st[1] = nx; }
        const unsigned old = xb_add(&bar[XB_XSUB(b.x)], 1u);
        const unsigned gen = old / nloc;
        if (old + 1u == (gen + 1u) * nloc) {
            __builtin_amdgcn_fence(__ATOMIC_RELEASE, "agent");
            asm volatile("s_waitcnt vmcnt(0)" ::: "memory");
            const unsigned og = xb_add(&bar[XB_TOP], 1u);
            const unsigned tg = og / nx;
            if (og + 1u == (tg + 1u) * nx) xb_add(&bar[XB_TOPGEN], 1u);
            else XB_SPIN(xb_ld(&bar[XB_TOPGEN]) == tg, bar);
            __builtin_amdgcn_fence(__ATOMIC_ACQUIRE, "agent");
            xb_add(&bar[XB_XGEN(b.x)], 1u);
            asm volatile("s_waitcnt vmcnt(0)" ::: "memory");
        } else {
            XB_SPIN(xb_ld(&bar[XB_XGEN(b.x)]) == gen, bar);
            __builtin_amdgcn_fence(__ATOMIC_ACQUIRE, "agent");
            asm volatile("s_waitcnt vmcnt(0)" ::: "memory");
        }
    }
    __syncthreads();
}

__global__ void __launch_bounds__(512, 2) hybrid_fwd(Params P) {
    extern __shared__ __attribute__((aligned(16))) unsigned char lds_raw[];
    LAS unsigned char* lds = (LAS unsigned char*)lds_raw;
    cg::grid_group grid = cg::this_grid();
    const int G = gridDim.x, NGW = G * 8;
#define PHASE_IDS const int tid = otid(), lane = tid & 63, wave = tid >> 6, gw = blockIdx.x * 8 + wave; (void)tid; (void)lane; (void)wave; (void)gw
    unsigned char* ws = P.ws;
    bf16_t* ZY = (bf16_t*)(ws + WS_ZY); bf16_t* R96 = (bf16_t*)(ws + WS_R96); bf16_t* XN = (bf16_t*)(ws + WS_XN);
    const bf16_t* Win = (const bf16_t*)(ws + WS_WIN); const bf16_t* Wssm = (const bf16_t*)(ws + WS_WSSM); const bf16_t* Watt = (const bf16_t*)(ws + WS_WATT);
    const bf16_t* Wmix = (const bf16_t*)(ws + WS_WMIX); const bf16_t* Wgu = (const bf16_t*)(ws + WS_WGU); const bf16_t* Wdn = (const bf16_t*)(ws + WS_WDN);
    float* DT = (float*)(ws + WS_DT); const float* ROPE = (const float*)(ws + WS_ROPE);
    bf16_t* GATES = (bf16_t*)P.out;
    float* F32 = (float*)(ws + WS_ZY);

    p0_prologue(P, lds, G);
#ifdef PROBE_P0
    __syncthreads(); p0_prologue(P, lds, G);
#endif
    { unsigned* bw = (unsigned*)(ws + WS_BAR); if (blockIdx.x == 0) for (int i = otid(); i < XCD_BAR_WORDS; i += 512) bw[i] = 0u;
      if (otid() < 2) ((volatile LAS unsigned*)(lds + 131072 + 64))[otid()] = 0u; }
    grid.sync();
    const XcdBarrier xbar = xcd_barrier_post((unsigned*)(ws + WS_BAR), (volatile LAS unsigned*)(lds + 131072 + 64));
#define GRID_BAR() xcd_barrier(xbar)
#ifdef PROBE_SYNC
    for (int i = 0; i < 10; ++i) GRID_BAR();
#endif
    { pg8::Gemm g{XN, Win, T_TOK, N1A, DM, DM}; pg8::StaticOrder S; S.init(T_TOK, N1A, G, (int)blockIdx.x);
      EpiP1a E{ZY, R96, DT, P.dt_bias};
      pg8::gemm_phase<EpiP1a, pg8::StaticOrder, true, true>(lds, g, S, E); }
    GRID_BAR();
#ifdef PROBE_SSD
    { const int one = oone(); for (int rep = 0; rep < 2; ++rep) for (int u = blockIdx.x; u < NB * NHS; u += G) ssd_unit(P, lds, u >> 5, u & 31, rep == one); }
#else
    for (int u = blockIdx.x; u < NB * NHS; u += G) ssd_unit(P, lds, u >> 5, u & 31);
#endif
    GRID_BAR();
    { pg8::Gemm g{XN, Win + (size_t)N1A * DM, T_TOK, N1B, DM, DM}; pg8::StaticOrder S; S.init(T_TOK, N1B, G, (int)blockIdx.x);
      EpiP1b E{R96, GATES, ROPE};
      pg8::gemm_phase<EpiP1b, pg8::StaticOrder, true, true>(lds, g, S, E); }
    GRID_BAR();
    {
        PHASE_IDS;
        LAS float* lamp = (LAS float*)(lds + 131072);
        if (wave == 0) { const float a = wave_sum(P.lq1[lane] * P.lk1[lane]), c = wave_sum(P.lq2[lane] * P.lk2[lane]); if (lane == 0) lamp[0] = expf(a) - expf(c) + LAM_INIT; }
        __syncthreads();
        const float lam = lamp[0];
#ifdef PROBE_ATT
        { const int one = oone(); for (int rep = 0; rep < 2; ++rep) for (int it = blockIdx.x; it < 256; it += G) {
            const int bh = it >> 2, s = it & 3;
            attn_unit(P, lds, bh >> 3, bh & 7, 7 - s, lam, rep == one);
            attn_unit(P, lds, bh >> 3, bh & 7, s, lam, rep == one);
        } }
#else
        for (int it = blockIdx.x; it < 256; it += G) {
            const int bh = it >> 2, s = it & 3;
            attn_unit(P, lds, bh >> 3, bh & 7, 7 - s, lam);
            attn_unit(P, lds, bh >> 3, bh & 7, s, lam);
        }
#endif
        for (int m = gw; m < T_TOK; m += NGW) ynorm_row(ZY + (size_t)m * DIN, lane);
    }
    GRID_BAR();
    { bf16_t* MIXIN = XN;
      { pg8::Gemm g{ZY, Wssm, T_TOK, DM, DIN, DIN}; pg8::StaticOrder S; S.init(T_TOK, DM, G, (int)blockIdx.x); EpiSsmOut E{MIXIN, GATES};
        pg8::gemm_phase<EpiSsmOut, pg8::StaticOrder, true, true>(lds, g, S, E); }
      { pg8::Gemm g{R96, Watt, T_TOK, DM, DM, XBCW}; pg8::StaticOrder S; S.init(T_TOK, DM, G, (int)blockIdx.x); EpiAttOut E{MIXIN, GATES};
        pg8::gemm_phase<EpiAttOut, pg8::StaticOrder, true, true>(lds, g, S, E); } }
    GRID_BAR();
    { pg8::Gemm g{XN, Wmix, T_TOK, DM, DM, DM}; pg8::StaticOrder S; S.init(T_TOK, DM, G, (int)blockIdx.x); EpiF32 E{F32};
      pg8::gemm_phase<EpiF32, pg8::StaticOrder, true, true>(lds, g, S, E); }
    GRID_BAR();
    { PHASE_IDS;
    for (int m = gw; m < T_TOK; m += NGW) row_pass5(F32 + (size_t)m * DM, P.x + (size_t)m * DM, P.n_post_mix, P.n_pre_ffn, P.out + (size_t)m * DM, XN + (size_t)m * DM, lane); }
    GRID_BAR();
    { pg8::Gemm g{XN, Wgu, T_TOK, 2 * FFH, DM, DM}; pg8::StaticOrder S; S.init(T_TOK, 2 * FFH, G, (int)blockIdx.x); EpiSwiglu E{R96};
      pg8::gemm_phase<EpiSwiglu, pg8::StaticOrder, true, true>(lds, g, S, E); }
    GRID_BAR();
    { pg8::Gemm g{R96, Wdn, T_TOK, DM, FFH, FFH}; pg8::StaticOrder S; S.init(T_TOK, DM, G, (int)blockIdx.x); EpiF32 E{F32};
      pg8::gemm_phase<EpiF32, pg8::StaticOrder, true, true>(lds, g, S, E); }
    GRID_BAR();
    { PHASE_IDS;
    for (int m = gw; m < T_TOK; m += NGW) row_pass8(F32 + (size_t)m * DM, P.n_post_ffn, P.out + (size_t)m * DM, lane); }
}

extern "C" void kernel_launch(void* const* d_in, const int* in_sizes, int n_in, void* d_out, int out_size, void* d_ws, size_t ws_size, hipStream_t stream) {
    static int grid = 0;
    if (grid == 0) {
        if (n_in != 24 || out_size != T_TOK * DM || ws_size < WS_END) { fprintf(stderr, "kernel_launch: unexpected shapes (n_in %d out %d ws %zu)\n", n_in, out_size, ws_size); grid = -1; return; }
        int dev = 0, cus = 0, per_cu = 0;
        hipGetDevice(&dev); hipDeviceGetAttribute(&cus, hipDeviceAttributeMultiprocessorCount, dev);
        hipFuncSetAttribute((const void*)hybrid_fwd, hipFuncAttributeMaxDynamicSharedMemorySize, LDS_BYTES);
        hipOccupancyMaxActiveBlocksPerMultiprocessor(&per_cu, (const void*)hybrid_fwd, 512, LDS_BYTES);
        if (per_cu < 1) { fprintf(stderr, "kernel_launch: occupancy query says %d blocks/CU\n", per_cu); per_cu = 1; }
        (void)hipGetLastError();
        grid = cus * 1;
    }
    if (grid < 0) return;
    Params p{};
    p.x = (const float*)d_in[0]; p.pos = (const int*)d_in[1]; p.w_in = (const float*)d_in[2]; p.conv_w = (const float*)d_in[3]; p.conv_b = (const float*)d_in[4];
    p.dt_bias = (const float*)d_in[5]; p.a_log = (const float*)d_in[6]; p.d_skip = (const float*)d_in[7]; p.ssm_norm_w = (const float*)d_in[8]; p.w_ssm_out = (const float*)d_in[9];
    p.lq1 = (const float*)d_in[10]; p.lk1 = (const float*)d_in[11]; p.lq2 = (const float*)d_in[12]; p.lk2 = (const float*)d_in[13]; p.subln_w = (const float*)d_in[14];
    p.w_attn_out = (const float*)d_in[15]; p.w_mix = (const float*)d_in[16]; p.n_pre_mix = (const float*)d_in[17]; p.n_post_mix = (const float*)d_in[18];
    p.n_pre_ffn = (const float*)d_in[19]; p.n_post_ffn = (const float*)d_in[20]; p.w_gate = (const float*)d_in[21]; p.w_up = (const float*)d_in[22]; p.w_down = (const float*)d_in[23];
    p.out = (float*)d_out; p.ws = (unsigned char*)d_ws;
    void* args[] = {&p};
    hipError_t e = hipLaunchCooperativeKernel((const void*)hybrid_fwd, dim3(grid), dim3(512), args, LDS_BYTES, stream);
    if (e != hipSuccess) fprintf(stderr, "cooperative launch failed: %s (grid %d)\n", hipGetErrorString(e), grid);
}
```

```cpp
#include <hip/hip_runtime.h>
#include <hip/hip_cooperative_groups.h>
#include <cstdio>
#include <cstdint>
namespace cg = cooperative_groups;

#define LAS __attribute__((address_space(3)))
typedef unsigned short bf16_t;
typedef short bf16x8 __attribute__((ext_vector_type(8)));
typedef short s16x4 __attribute__((ext_vector_type(4)));
typedef float f32x4 __attribute__((ext_vector_type(4)));
typedef float f32x16 __attribute__((ext_vector_type(16)));
typedef unsigned u32x4 __attribute__((ext_vector_type(4)));
typedef unsigned u32x2 __attribute__((ext_vector_type(2)));
typedef float f32x2_t __attribute__((ext_vector_type(2)));
typedef __bf16 bf16x2_t __attribute__((ext_vector_type(2)));
#define DI __device__ __forceinline__

DI int otid() { int t = threadIdx.x; asm volatile("" : "+v"(t)); return t; }
DI int oone() { int t = 1; asm volatile("" : "+s"(t)); return t; }
DI unsigned cvtpk(float lo, float hi) { f32x2_t v = {lo, hi}; bf16x2_t b = __builtin_convertvector(v, bf16x2_t); return __builtin_bit_cast(unsigned, b); }
DI float bflo(unsigned w) { return __uint_as_float(w << 16); }
DI float bfhi(unsigned w) { return __uint_as_float(w & 0xffff0000u); }
DI float silu_f(float x) { return x / (1.f + __expf(-x)); }
DI float sigmoid_f(float x) { return 1.f / (1.f + __expf(-x)); }

constexpr int T_TOK = 16384, SEQ = 2048, DM = 1024, NB = 8;
constexpr int NHS = 32, DIN = 2048, XBCW = 3072, FFH = 2816;
constexpr int N1A = 5120, N1B = 5120, N1B_ROW0 = 5376;
constexpr float EPS = 1e-6f;
constexpr float QSCALE = 0.125f * 1.4426950408889634f;
constexpr float LAM_INIT = 0.2f;

constexpr size_t MiB = 1u << 20;
constexpr size_t WS_ZY = 0, WS_R96 = 64 * MiB, WS_XN = 160 * MiB, WS_WIN = 192 * MiB, WS_WSSM = 213 * MiB, WS_WATT = 217 * MiB, WS_WMIX = 219 * MiB,
                 WS_WGU = 221 * MiB, WS_WDN = 232 * MiB, WS_DT = 238 * MiB, WS_ROPE = 240 * MiB, WS_BAR = 241 * MiB, WS_END = 242 * MiB;
constexpr int LDS_BYTES = 147456;

struct Params {
    const float* x; const int* pos; const float* w_in; const float* conv_w; const float* conv_b; const float* dt_bias; const float* a_log; const float* d_skip;
    const float* ssm_norm_w; const float* w_ssm_out; const float* lq1; const float* lk1; const float* lq2; const float* lk2; const float* subln_w; const float* w_attn_out;
    const float* w_mix; const float* n_pre_mix; const float* n_post_mix; const float* n_pre_ffn; const float* n_post_ffn; const float* w_gate; const float* w_up; const float* w_down;
    float* out; unsigned char* ws;
};

namespace pg8 {
#define PG8_LAS __attribute__((address_space(3)))
constexpr int BM = 256, BK = 64, HALF = 128, HTB = HALF * BK * 2, STAGE_BYTES = 8 * HTB, NXCD = 8, WGM = 8;
__host__ __device__ __forceinline__ int lds_byte(int r, int c) { const int st = (r >> 4) * 2 + (c >> 5), rr = r & 15, cc = c & 31, ob = rr * 64 + cc * 2; return st * 1024 + (ob ^ (((ob >> 9) & 1) << 5)); }
__host__ __device__ __forceinline__ void stage_rc(int b, int& R, int& C) { const int st = b / 1024, sb = b % 1024, swz = sb ^ (((sb >> 9) & 1) << 5); R = (st >> 1) * 16 + swz / 64; C = (st & 1) * 32 + (swz % 64) / 2; }
__host__ __device__ __forceinline__ int perm32(int rho) { const int n = rho >> 4, i = rho & 15; return 8 * (i >> 2) + 4 * n + (i & 3); }
struct Unit { int pm, pn; };
struct Gemm { const bf16_t* A; const bf16_t* Bt; int M, N, K, lda; };
struct StaticOrder {
    int nM, nN, nwg, G, c;
    __host__ __device__ void init(int M, int N, int G_, int c_) { nM = M / BM; nN = N / BM; nwg = nM * nN; G = G_; c = c_; }
    __host__ __device__ bool next(int i, Unit& u) const {
        const long L = (long)i * G + c; if (L >= nwg) return false;
        int wgid = (int)L; { const int q = nwg / NXCD, r = nwg % NXCD, xcd = wgid % NXCD, off = wgid / NXCD; wgid = (xcd < r ? xcd * (q + 1) : r * (q + 1) + (xcd - r) * q) + off; }
        const int nig = WGM * nN, gid = wgid / nig, fm = gid * WGM, gsz = (nM - fm) < WGM ? (nM - fm) : WGM;
        u.pm = fm + ((wgid % nig) % gsz); u.pn = (wgid % nig) / gsz; return true;
    }
};
template <class Epi, class Sched, bool ALIGN_EPI, bool SP2>
__device__ __forceinline__ void gemm_phase(PG8_LAS unsigned char* lds, const Gemm g, const Sched& S, const Epi& E) {
    const int tid = otid(), wid = __builtin_amdgcn_readfirstlane(tid >> 6), lane = tid & 63, wr = wid >> 2, wc = wid & 3, fr = lane & 15, fq = lane >> 4;
    const int K = g.K, nt = K / BK, lda = g.lda;
    unsigned voffA[2], voffB[2];
#pragma unroll
    for (int i = 0; i < 2; ++i) { int R, C; stage_rc(tid * 16 + i * 8192, R, C); const int Rb = Epi::PERM ? ((R & ~31) + perm32(R & 31)) : R;
        voffA[i] = (unsigned)(R * lda + C) * 2u; voffB[i] = (unsigned)(Rb * K + C) * 2u; }
    const size_t kstep = (size_t)(BK * 2);
    const size_t hstepA = (size_t)HALF * lda * 2, hstepB = (size_t)HALF * K * 2;
    const size_t tstepA = 2 * hstepA, tstepB = 2 * hstepB;
    const unsigned ldsw = (unsigned)wid * 1024u;
    const int aoff = lds_byte(wr * 64 + fr, fq * 8), boff = lds_byte(wc * 32 + fr, fq * 8);
#define PG8_SA(b, h) (((b) * 2 + (h)) * HTB)
#define PG8_SB(b, h) ((4 + (b) * 2 + (h)) * HTB)
#define PG8_STAGE(bufoff, gbase, voff) do { _Pragma("unroll") for (int _i = 0; _i < 2; ++_i) \
        __builtin_amdgcn_global_load_lds((const unsigned*)((const char*)(gbase) + (voff)[_i]), (PG8_LAS unsigned*)(lds + (bufoff) + ldsw + _i * 8192), 16, 0, 0); } while (0)
#define PG8_LDA(dst, b, h) do { _Pragma("unroll") for (int m = 0; m < 4; ++m) _Pragma("unroll") for (int k = 0; k < 2; ++k) dst[m][k] = *(const PG8_LAS bf16x8*)(lds + PG8_SA(b, h) + aoff + m * 2048 + k * 1024); } while (0)
#define PG8_LDB(dst, b, h) do { _Pragma("unroll") for (int n = 0; n < 2; ++n) _Pragma("unroll") for (int k = 0; k < 2; ++k) dst[n][k] = *(const PG8_LAS bf16x8*)(lds + PG8_SB(b, h) + boff + n * 2048 + k * 1024); } while (0)
#define PG8_MMA(ai, bj, At, Bt) do { __builtin_amdgcn_s_setprio(1); _Pragma("unroll") for (int m = 0; m < 4; ++m) _Pragma("unroll") for (int n = 0; n < 2; ++n) _Pragma("unroll") for (int k = 0; k < 2; ++k) \
        acc[ai][bj][m][n] = __builtin_amdgcn_mfma_f32_16x16x32_bf16(Bt[n][k], At[m][k], acc[ai][bj][m][n], 0, 0, 0); __builtin_amdgcn_s_setprio(0); } while (0)
#define PG8_WAIT_V(n) asm volatile("s_waitcnt vmcnt(" #n ")" ::: "memory")
#define PG8_WAIT_L(n) asm volatile("s_waitcnt lgkmcnt(" #n ")" ::: "memory")
#define PG8_BAR __builtin_amdgcn_s_barrier()
#define PG8_SCHED __builtin_amdgcn_sched_barrier(0)
    Unit cur, nxt; int ui = 0;
    if (!S.next(0, cur)) return;
    f32x4 acc[2][2][4][2];
#pragma unroll
    for (int a = 0; a < 2; ++a)
#pragma unroll
        for (int b = 0; b < 2; ++b)
#pragma unroll
            for (int m = 0; m < 4; ++m)
#pragma unroll
                for (int n = 0; n < 2; ++n) acc[a][b][m][n] = (f32x4){0.f, 0.f, 0.f, 0.f};
    bf16x8 At[4][2], B0[2][2], B1[2][2];
    const char* cA = (const char*)g.A + (size_t)cur.pm * tstepA; const char* cB = (const char*)g.Bt + (size_t)cur.pn * tstepB;
    if constexpr (SP2) {
        PG8_STAGE(PG8_SB(0, 0), cB, voffB); PG8_STAGE(PG8_SB(0, 1), cB + hstepB, voffB); PG8_STAGE(PG8_SA(0, 0), cA, voffA); PG8_STAGE(PG8_SA(0, 1), cA + hstepA, voffA);
        if (wr == 1) PG8_BAR;
        PG8_WAIT_V(2); PG8_BAR;
        PG8_STAGE(PG8_SB(1, 0), cB + kstep, voffB); PG8_STAGE(PG8_SA(1, 0), cA + kstep, voffA); PG8_STAGE(PG8_SB(1, 1), cB + hstepB + kstep, voffB);
        PG8_WAIT_V(6); PG8_BAR;
    }
    for (;;) {
        const bool has_next = S.next(ui + 1, nxt);
        const char* nA = has_next ? (const char*)g.A + (size_t)nxt.pm * tstepA : cA; const char* nB = has_next ? (const char*)g.Bt + (size_t)nxt.pn * tstepB : cB;
        for (int t = 0; t < nt; t += 2) {
            const bool last = (t == nt - 2);
            const char* a1 = cA + (size_t)(t + 1) * kstep;
            const char* a2 = last ? nA : cA + (size_t)(t + 2) * kstep; const char* b2 = last ? nB : cB + (size_t)(t + 2) * kstep;
            const char* a3 = a2 + kstep; const char* b3 = b2 + kstep;
            PG8_LDB(B0, 0, 0); PG8_LDB(B1, 0, 1); PG8_SCHED; PG8_LDA(At, 0, 0); PG8_STAGE(PG8_SA(1, 1), a1 + hstepA, voffA);
            PG8_WAIT_V(8); PG8_WAIT_L(0); PG8_BAR; PG8_MMA(0, 0, At, B0); PG8_MMA(0, 1, At, B1); PG8_BAR; PG8_SCHED;
            PG8_LDA(At, 0, 1); PG8_STAGE(PG8_SB(0, 0), b2, voffB); PG8_STAGE(PG8_SB(0, 1), b2 + hstepB, voffB); PG8_STAGE(PG8_SA(0, 0), a2, voffA);
            PG8_WAIT_V(8); PG8_WAIT_L(0); PG8_BAR; PG8_MMA(1, 0, At, B0); PG8_MMA(1, 1, At, B1); PG8_BAR; PG8_SCHED;
            PG8_LDB(B0, 1, 0); PG8_LDB(B1, 1, 1); PG8_SCHED; PG8_LDA(At, 1, 0); PG8_STAGE(PG8_SA(0, 1), a2 + hstepA, voffA);
            PG8_WAIT_V(8); PG8_WAIT_L(0); PG8_BAR; PG8_MMA(0, 0, At, B0); PG8_MMA(0, 1, At, B1); PG8_BAR; PG8_SCHED;
            PG8_LDA(At, 1, 1); PG8_STAGE(PG8_SB(1, 0), b3, voffB); PG8_STAGE(PG8_SB(1, 1), b3 + hstepB, voffB); PG8_STAGE(PG8_SA(1, 0), a3, voffA);
            PG8_WAIT_V(8); PG8_WAIT_L(0); PG8_BAR; PG8_MMA(1, 0, At, B0); PG8_MMA(1, 1, At, B1); PG8_BAR; PG8_SCHED;
        }
        if constexpr (ALIGN_EPI) { if (wr == 0) PG8_BAR; }
        E(acc, cur, wr, wc, fr, fq);
        if (!has_next) break;
#pragma unroll
        for (int a = 0; a < 2; ++a)
#pragma unroll
            for (int b = 0; b < 2; ++b)
#pragma unroll
                for (int m = 0; m < 4; ++m)
#pragma unroll
                    for (int n = 0; n < 2; ++n) acc[a][b][m][n] = (f32x4){0.f, 0.f, 0.f, 0.f};
        cur = nxt; cA = nA; cB = nB; ++ui;
        if constexpr (ALIGN_EPI) { if (wr == 1) PG8_BAR; }
    }
    PG8_WAIT_V(0);
    if constexpr (!ALIGN_EPI) { if (wr == 0) PG8_BAR; }
    PG8_BAR;
#undef PG8_SA
#undef PG8_SB
#undef PG8_STAGE
#undef PG8_LDA
#undef PG8_LDB
#undef PG8_MMA
#undef PG8_WAIT_V
#undef PG8_WAIT_L
#undef PG8_BAR
#undef PG8_SCHED
}
}
using pg8::Unit;
typedef const f32x4 (&AccRef)[2][2][4][2];

DI void st8(bf16_t* p, f32x4 v0, f32x4 v1) { u32x4 w; w.x = cvtpk(v0[0], v0[1]); w.y = cvtpk(v0[2], v0[3]); w.z = cvtpk(v1[0], v1[1]); w.w = cvtpk(v1[2], v1[3]); *(u32x4*)p = w; }

struct EpiP1a {
    static constexpr bool PERM = true;
    bf16_t* ZY; bf16_t* XBC; float* DT; const float* dt_bias;
    DI void operator()(AccRef acc, const Unit& u, int wr, int wc, int fr, int fq) const {
        const int row0 = u.pm * 256 + wr * 64 + fr;
        if (u.pn < 20) {
            const bool isz = u.pn < 8;
            bf16_t* base = isz ? ZY : XBC; const int ld = isz ? DIN : XBCW; const int col0 = (isz ? u.pn : u.pn - 8) * 256 + wc * 32 + 8 * fq;
#pragma unroll
            for (int ai = 0; ai < 2; ++ai)
#pragma unroll
                for (int m = 0; m < 4; ++m) { bf16_t* rowp = base + (size_t)(row0 + ai * 128 + m * 16) * ld + col0;
#pragma unroll
                    for (int bj = 0; bj < 2; ++bj) { f32x4 v0 = acc[ai][bj][m][0], v1 = acc[ai][bj][m][1];
                        if (isz) {
#pragma unroll
                            for (int j = 0; j < 4; ++j) { v0[j] = silu_f(v0[j]); v1[j] = silu_f(v1[j]); } }
                        st8(rowp + bj * 128, v0, v1); } }
        } else if (wc == 0) {
            const int c0 = 8 * fq;
            const f32x4 b0 = *(const f32x4*)(dt_bias + c0), b1 = *(const f32x4*)(dt_bias + c0 + 4);
#pragma unroll
            for (int ai = 0; ai < 2; ++ai)
#pragma unroll
                for (int m = 0; m < 4; ++m) { float* rowp = DT + (size_t)(row0 + ai * 128 + m * 16) * NHS + c0;
                    f32x4 v0 = acc[ai][0][m][0] + b0, v1 = acc[ai][0][m][1] + b1;
#pragma unroll
                    for (int j = 0; j < 4; ++j) { v0[j] = v0[j] > 20.f ? v0[j] : log1pf(__expf(v0[j])); v1[j] = v1[j] > 20.f ? v1[j] : log1pf(__expf(v1[j])); }
                    *(f32x4*)rowp = v0; *(f32x4*)(rowp + 4) = v1; }
        }
    }
};
struct EpiP1b {
    static constexpr bool PERM = true;
    bf16_t* QKV; bf16_t* GATES; const float* ROPE;
    DI void operator()(AccRef acc, const Unit& u, int wr, int wc, int fr, int fq) const {
        const int row0 = u.pm * 256 + wr * 64 + fr;
        const bool isg = u.pn >= 12;
        bf16_t* base = isg ? GATES : QKV; const int ld = isg ? DIN : XBCW; const int col0 = (isg ? u.pn - 12 : u.pn) * 256 + wc * 32 + 8 * fq;
        const bool rope = (u.pn < 8) && ((wc & 1) == 0);
        const float sc = (u.pn < 4) ? QSCALE : 1.f;
#pragma unroll
        for (int ai = 0; ai < 2; ++ai)
#pragma unroll
            for (int m = 0; m < 4; ++m) { const int row = row0 + ai * 128 + m * 16; bf16_t* rowp = base + (size_t)row * ld + col0;
                f32x4 c0v, c1v, s0v, s1v;
                if (rope) { const float* rp = ROPE + (size_t)row * 16; c0v = *(const f32x4*)rp; c1v = *(const f32x4*)(rp + 4); s0v = *(const f32x4*)(rp + 8); s1v = *(const f32x4*)(rp + 12);
                    if (fq == 1) { s0v = -s0v; s1v = -s1v; } }
#pragma unroll
                for (int bj = 0; bj < 2; ++bj) { f32x4 v0 = acc[ai][bj][m][0], v1 = acc[ai][bj][m][1];
                    if (isg) {
#pragma unroll
                        for (int j = 0; j < 4; ++j) { v0[j] = sigmoid_f(v0[j]); v1[j] = sigmoid_f(v1[j]); }
                    } else if (rope) {
                        f32x4 p0, p1;
#pragma unroll
                        for (int j = 0; j < 4; ++j) { p0[j] = __shfl_xor(v0[j], 16); p1[j] = __shfl_xor(v1[j], 16); }
                        if (fq < 2) { v0 = v0 * c0v - p0 * s0v; v1 = v1 * c1v - p1 * s1v; }
                    }
                    v0 = v0 * sc; v1 = v1 * sc;
                    st8(rowp + bj * 128, v0, v1); } }
    }
};
struct EpiSsmOut {
    static constexpr bool PERM = true;
    bf16_t* MIXIN; const bf16_t* GATES;
    DI void operator()(AccRef acc, const Unit& u, int wr, int wc, int fr, int fq) const {
        const int row0 = u.pm * 256 + wr * 64 + fr, col0 = u.pn * 256 + wc * 32 + 8 * fq;
#pragma unroll
        for (int ai = 0; ai < 2; ++ai)
#pragma unroll
            for (int m = 0; m < 4; ++m) { const int row = row0 + ai * 128 + m * 16;
#pragma unroll
                for (int bj = 0; bj < 2; ++bj) { const u32x4 gw = *(const u32x4*)(GATES + (size_t)row * DIN + col0 + bj * 128);
                    f32x4 v0 = acc[ai][bj][m][0], v1 = acc[ai][bj][m][1];
                    v0[0] *= bflo(gw.x); v0[1] *= bfhi(gw.x); v0[2] *= bflo(gw.y); v0[3] *= bfhi(gw.y); v1[0] *= bflo(gw.z); v1[1] *= bfhi(gw.z); v1[2] *= bflo(gw.w); v1[3] *= bfhi(gw.w);
                    st8(MIXIN + (size_t)row * DM + col0 + bj * 128, v0, v1); } }
    }
};
struct EpiAttOut {
    static constexpr bool PERM = true;
    bf16_t* MIXIN; const bf16_t* GATES;
    DI void operator()(AccRef acc, const Unit& u, int wr, int wc, int fr, int fq) const {
        const int row0 = u.pm * 256 + wr * 64 + fr, col0 = u.pn * 256 + wc * 32 + 8 * fq;
#pragma unroll
        for (int ai = 0; ai < 2; ++ai)
#pragma unroll
            for (int m = 0; m < 4; ++m) { const int row = row0 + ai * 128 + m * 16;
#pragma unroll
                for (int bj = 0; bj < 2; ++bj) { const u32x4 gw = *(const u32x4*)(GATES + (size_t)row * DIN + DM + col0 + bj * 128);
                    bf16_t* mp = MIXIN + (size_t)row * DM + col0 + bj * 128; const u32x4 pw = *(const u32x4*)mp;
                    f32x4 v0 = acc[ai][bj][m][0], v1 = acc[ai][bj][m][1];
                    v0[0] = v0[0] * bflo(gw.x) + bflo(pw.x); v0[1] = v0[1] * bfhi(gw.x) + bfhi(pw.x); v0[2] = v0[2] * bflo(gw.y) + bflo(pw.y); v0[3] = v0[3] * bfhi(gw.y) + bfhi(pw.y);
                    v1[0] = v1[0] * bflo(gw.z) + bflo(pw.z); v1[1] = v1[1] * bfhi(gw.z) + bfhi(pw.z); v1[2] = v1[2] * bflo(gw.w) + bflo(pw.w); v1[3] = v1[3] * bfhi(gw.w) + bfhi(pw.w);
                    st8(mp, v0, v1); } }
    }
};
struct EpiF32 {
    static constexpr bool PERM = false;
    float* O;
    DI void operator()(AccRef acc, const Unit& u, int wr, int wc, int fr, int fq) const {
        const int row0 = u.pm * 256 + wr * 64 + fr, col0 = u.pn * 256 + wc * 32 + 4 * fq;
#pragma unroll
        for (int ai = 0; ai < 2; ++ai)
#pragma unroll
            for (int m = 0; m < 4; ++m) { float* rowp = O + (size_t)(row0 + ai * 128 + m * 16) * DM + col0;
#pragma unroll
                for (int bj = 0; bj < 2; ++bj)
#pragma unroll
                    for (int n = 0; n < 2; ++n) *(f32x4*)(rowp + bj * 128 + n * 16) = acc[ai][bj][m][n]; }
    }
};
struct EpiSwiglu {
    static constexpr bool PERM = true;
    bf16_t* HID;
    DI void operator()(AccRef acc, const Unit& u, int wr, int wc, int fr, int fq) const {
        const int row0 = u.pm * 256 + wr * 64 + fr, col0 = u.pn * 128 + wc * 32 + 8 * fq;
#pragma unroll
        for (int ai = 0; ai < 2; ++ai)
#pragma unroll
            for (int m = 0; m < 4; ++m) { f32x4 v0, v1;
#pragma unroll
                for (int j = 0; j < 4; ++j) { v0[j] = silu_f(acc[ai][0][m][0][j]) * acc[ai][1][m][0][j]; v1[j] = silu_f(acc[ai][0][m][1][j]) * acc[ai][1][m][1][j]; }
                st8(HID + (size_t)(row0 + ai * 128 + m * 16) * FFH + col0, v0, v1); }
    }
};

DI float wave_sum(float v) {
#pragma unroll
    for (int o = 1; o < 64; o <<= 1) v += __shfl_xor(v, o);
    return v;
}
DI void transpose_item(const float* W, int ldw, int src_n0, int k0, bf16_t* WT, int ldt, int dst_row0, const float* kscale, LAS float* scr, int lane) {
#pragma unroll 8
    for (int i = 0; i < 32; ++i) { const int kk = 2 * i + (lane >> 5); float v = W[(size_t)(k0 + kk) * ldw + src_n0 + (lane & 31)]; if (kscale) v *= kscale[k0 + kk]; scr[kk * 33 + (lane & 31)] = v; }
    asm volatile("s_waitcnt lgkmcnt(0)" ::: "memory");
    const int c = lane & 7;
#pragma unroll
    for (int j = 0; j < 4; ++j) { const int n = (lane >> 3) + 8 * j; const LAS float* s = scr + (8 * c) * 33 + n;
        u32x4 o; o.x = cvtpk(s[0 * 33], s[1 * 33]); o.y = cvtpk(s[2 * 33], s[3 * 33]); o.z = cvtpk(s[4 * 33], s[5 * 33]); o.w = cvtpk(s[6 * 33], s[7 * 33]);
        *(u32x4*)(WT + (size_t)(dst_row0 + n) * ldt + k0 + 8 * c) = o; }
    asm volatile("s_waitcnt lgkmcnt(0)" ::: "memory");
}
DI void rms_row_to_bf16(const float* xrow, const float* w, bf16_t* orow, int lane) {
    const f32x4* xr = (const f32x4*)xrow + lane; const f32x4* wr_ = (const f32x4*)w + lane;
    f32x4 v[4]; float s = 0.f;
#pragma unroll
    for (int j = 0; j < 4; ++j) { v[j] = xr[64 * j]; s += (v[j].x * v[j].x + v[j].y * v[j].y) + (v[j].z * v[j].z + v[j].w * v[j].w); }
    const float rstd = rsqrtf(wave_sum(s) * (1.f / DM) + EPS);
    u32x2* o8 = (u32x2*)orow + lane;
#pragma unroll
    for (int j = 0; j < 4; ++j) { const f32x4 g = wr_[64 * j]; u32x2 o; o.x = cvtpk(v[j].x * rstd * g.x, v[j].y * rstd * g.y); o.y = cvtpk(v[j].z * rstd * g.z, v[j].w * rstd * g.w); o8[64 * j] = o; }
}

DI void p0_prologue(const Params& P, LAS unsigned char* lds, int G) {
    const int tid = otid(), lane = tid & 63, wave = tid >> 6;
    LAS float* scr = (LAS float*)(lds + wave * 16384);
    const int gw = blockIdx.x * 8 + wave, NGW = G * 8;
    unsigned char* ws = P.ws;
    bf16_t* Win = (bf16_t*)(ws + WS_WIN); bf16_t* Wssm = (bf16_t*)(ws + WS_WSSM); bf16_t* Watt = (bf16_t*)(ws + WS_WATT); bf16_t* Wmix = (bf16_t*)(ws + WS_WMIX);
    bf16_t* Wgu = (bf16_t*)(ws + WS_WGU); bf16_t* Wdn = (bf16_t*)(ws + WS_WDN);
    constexpr int INC = 10272;
    constexpr int I_IN = 16 * 320, I_DT = 16, I_SSM = 32 * 32, I_ATT = 16 * 32, I_MIX = 16 * 32, I_G = 16 * 88, I_U = 16 * 88, I_D = 44 * 32;
    constexpr int NIT = I_IN + I_DT + I_SSM + I_ATT + I_MIX + I_G + I_U + I_D;
    for (int it = gw; it < NIT; it += NGW) {
        int r = it;
        if (r < I_IN) { const int kb = r / 320, nb = r % 320; const int n0 = nb * 32;
            const int src = n0 < 5120 ? n0 : n0 + 32; const int dst = n0 < 5120 ? n0 : n0 + 256;
            transpose_item(P.w_in, INC, src, kb * 64, Win, DM, dst, nullptr, scr, lane); continue; } r -= I_IN;
        if (r < I_DT) { transpose_item(P.w_in, INC, 5120, r * 64, Win, DM, 5120, nullptr, scr, lane); continue; } r -= I_DT;
        if (r < I_SSM) { const int kb = r / 32, nb = r % 32; transpose_item(P.w_ssm_out, DM, nb * 32, kb * 64, Wssm, DIN, nb * 32, P.ssm_norm_w, scr, lane); continue; } r -= I_SSM;
        if (r < I_ATT) { const int kb = r / 32, nb = r % 32; transpose_item(P.w_attn_out, DM, nb * 32, kb * 64, Watt, DM, nb * 32, nullptr, scr, lane); continue; } r -= I_ATT;
        if (r < I_MIX) { const int kb = r / 32, nb = r % 32; transpose_item(P.w_mix, DM, nb * 32, kb * 64, Wmix, DM, nb * 32, nullptr, scr, lane); continue; } r -= I_MIX;
        if (r < I_G) { const int kb = r / 88, nb = r % 88; const int n0 = nb * 32; transpose_item(P.w_gate, FFH, n0, kb * 64, Wgu, DM, 256 * (n0 >> 7) + (n0 & 127), nullptr, scr, lane); continue; } r -= I_G;
        if (r < I_U) { const int kb = r / 88, nb = r % 88; const int n0 = nb * 32; transpose_item(P.w_up, FFH, n0, kb * 64, Wgu, DM, 256 * (n0 >> 7) + 128 + (n0 & 127), nullptr, scr, lane); continue; } r -= I_U;
        { const int kb = r / 32, nb = r % 32; transpose_item(P.w_down, DM, nb * 32, kb * 64, Wdn, FFH, nb * 32, nullptr, scr, lane); }
    }
    bf16_t* XN = (bf16_t*)(ws + WS_XN);
    for (int m = gw; m < T_TOK; m += NGW) rms_row_to_bf16(P.x + (size_t)m * DM, P.n_pre_mix, XN + (size_t)m * DM, lane);
    float* ROPE = (float*)(ws + WS_ROPE);
    for (int e = blockIdx.x * 512 + tid; e < T_TOK * 8; e += G * 512) {
        const int t = e >> 3, i = e & 7;
        const float invf = i == 0 ? 1.0f : i == 1 ? 0.1939227432012558f : i == 2 ? 0.03760603070259094f : i == 3 ? 0.007292664609849453f : i == 4 ? 0.0014142135623842478f
                          : i == 5 ? 0.00027424818836152554f : i == 6 ? 5.318296098266728e-05f : 1.0313386155758053e-05f;
        const float ang = (float)P.pos[t] * invf;
        const double a = (double)ang; const double k = rint(a * 0.15915494309189535); const double rr = a - k * 6.283185307179586;
        const float rf = (float)rr;
        ROPE[t * 16 + i] = __cosf(rf); ROPE[t * 16 + 8 + i] = __sinf(rf);
    }
}

DI s16x4 trrd(const LAS unsigned char* p) { return __builtin_bit_cast(s16x4, __builtin_amdgcn_ds_read_tr16_b64_v4i16((LAS s16x4*)p)); }
DI bf16x8 cat8(s16x4 lo, s16x4 hi) { return __builtin_shufflevector(lo, hi, 0, 1, 2, 3, 4, 5, 6, 7); }
#define MFMA32(a, b, c) __builtin_amdgcn_mfma_f32_32x32x16_bf16((a), (b), (c), 0, 0, 0)
DI int crow(int i, int hi) { return (i & 3) + 8 * (i >> 2) + 4 * hi; }

constexpr int SS_BC = 272, SS_X = 144;
constexpr int L_CS = 0, L_BS = L_CS + 128 * SS_BC, L_HS = L_BS + 128 * SS_BC, L_XS = L_HS + 64 * SS_BC, L_XW = L_XS + 128 * SS_X, L_DT = L_XW + 128 * SS_X, L_DA = L_DT + 512, L_ACS = L_DA + 512, L_SSD_END = L_ACS + 512;
static_assert(L_SSD_END <= 131072, "ssd lds");

template <int R> DI void conv_load(const bf16_t* XBC, int t0, int r0, bool first, int col, u32x4 (&in)[R + 3]) {
#pragma unroll
    for (int i = 0; i < R + 3; ++i) { const int rr = r0 - 3 + i; if (first && rr < 0) in[i] = (u32x4){0u, 0u, 0u, 0u}; else in[i] = *(const u32x4*)(XBC + (size_t)(t0 + rr) * XBCW + col); }
}
template <int R> DI void conv_apply(const u32x4 (&in)[R + 3], int col, const float* conv_w, const float* conv_b, float (&outv)[R][8]) {
    float w[4][8], bsv[8];
#pragma unroll
    for (int j = 0; j < 4; ++j) { const f32x4 a = *(const f32x4*)(conv_w + j * XBCW + col), b = *(const f32x4*)(conv_w + j * XBCW + col + 4);
        w[j][0] = a.x; w[j][1] = a.y; w[j][2] = a.z; w[j][3] = a.w; w[j][4] = b.x; w[j][5] = b.y; w[j][6] = b.z; w[j][7] = b.w; }
    { const f32x4 a = *(const f32x4*)(conv_b + col), b = *(const f32x4*)(conv_b + col + 4); bsv[0] = a.x; bsv[1] = a.y; bsv[2] = a.z; bsv[3] = a.w; bsv[4] = b.x; bsv[5] = b.y; bsv[6] = b.z; bsv[7] = b.w; }
#pragma unroll
    for (int r = 0; r < R; ++r) {
#pragma unroll
        for (int c = 0; c < 8; ++c) outv[r][c] = bsv[c];
#pragma unroll
        for (int j = 0; j < 4; ++j) { const u32x4 v = in[r + j];
            outv[r][0] += w[j][0] * bflo(v.x); outv[r][1] += w[j][1] * bfhi(v.x); outv[r][2] += w[j][2] * bflo(v.y); outv[r][3] += w[j][3] * bfhi(v.y);
            outv[r][4] += w[j][4] * bflo(v.z); outv[r][5] += w[j][5] * bfhi(v.z); outv[r][6] += w[j][6] * bflo(v.w); outv[r][7] += w[j][7] * bfhi(v.w); }
#pragma unroll
        for (int c = 0; c < 8; ++c) outv[r][c] = silu_f(outv[r][c]);
    }
}

DI void p1c_prepass(const Params& P, int G) {
    const int tid = otid(), lane = tid & 63, wave = tid >> 6, r32 = lane & 31, hi = lane >> 5;
    const bf16_t* XBC = (const bf16_t*)(P.ws + WS_R96); bf16_t* BCc = (bf16_t*)P.out;
    for (int it = blockIdx.x * 512 + tid; it < (T_TOK / 8) * 128; it += G * 512) {
        const int cg8 = it & 127, seg = it >> 7; const int t0 = seg * 8; const bool first = (t0 & (SEQ - 1)) == 0;
        const int col = DIN + cg8 * 8;
        u32x4 in[11]; conv_load<8>(XBC, t0, 0, first, col, in);
        float ov[8][8]; conv_apply<8>(in, col, P.conv_w, P.conv_b, ov);
#pragma unroll
        for (int r = 0; r < 8; ++r) { u32x4 w; w.x = cvtpk(ov[r][0], ov[r][1]); w.y = cvtpk(ov[r][2], ov[r][3]); w.z = cvtpk(ov[r][4], ov[r][5]); w.w = cvtpk(ov[r][6], ov[r][7]);
            *(u32x4*)(BCc + (size_t)(t0 + r) * 1024 + cg8 * 8) = w; }
    }
    const int gw = blockIdx.x * 8 + wave;
    if ((gw & 3) == 0 && (gw >> 2) < T_TOK / 32) {
        const int rb = gw >> 2;
        const bf16_t* ap = (const bf16_t*)(P.ws + WS_XN) + (size_t)(32 * rb + r32) * DM + 8 * hi;
        const bf16_t* bp = (const bf16_t*)(P.ws + WS_WIN) + (size_t)(5120 + r32) * DM + 8 * hi;
        f32x16 acc;
#pragma unroll
        for (int i = 0; i < 16; ++i) acc[i] = 0.f;
#pragma unroll 8
        for (int ks = 0; ks < 64; ++ks) { const bf16x8 a = *(const bf16x8*)(ap + 16 * ks), bb = *(const bf16x8*)(bp + 16 * ks); acc = MFMA32(a, bb, acc); }
        float* DT = (float*)(P.ws + WS_DT); const float bias = P.dt_bias[r32];
#pragma unroll
        for (int i = 0; i < 16; ++i) { float v = acc[i] + bias; v = v > 20.f ? v : log1pf(__expf(v)); DT[(size_t)(32 * rb + crow(i, hi)) * NHS + r32] = v; }
    }
}

DI void ssd_unit(const Params& P, LAS unsigned char* lds, int b, int h, bool dostore = true) {
    const int tid = otid(), lane = tid & 63, wid = __builtin_amdgcn_readfirstlane(tid >> 6), r32 = lane & 31, hi = lane >> 5;
    const int q4 = (lane & 15) >> 2, p4 = lane & 3, g1 = (lane >> 4) & 1;
    const int g = h >> 3;
    bf16_t* ZY = (bf16_t*)(P.ws + WS_ZY); const bf16_t* XBC = (const bf16_t*)(P.ws + WS_R96); const float* DT = (const float*)(P.ws + WS_DT); const bf16_t* BCc = (const bf16_t*)P.out;
    const float Ah = -__expf(P.a_log[h]), Dh = P.d_skip[h];
    LAS float* sm_dt = (LAS float*)(lds + L_DT); LAS float* sm_acs = (LAS float*)(lds + L_ACS);
    const int pb = wid & 1, lb = wid >> 1;
    f32x16 hacc;
#pragma unroll
    for (int i = 0; i < 16; ++i) hacc[i] = 0.f;
    const int bcch = tid & 31, bcrow = tid >> 5;
    const bf16_t* bcsrc = BCc + (size_t)(b * SEQ + bcrow) * 1024 + (bcch < 16 ? g * 128 + bcch * 8 : 512 + g * 128 + (bcch - 16) * 8);
    LAS unsigned char* bcdst = lds + (bcch < 16 ? L_BS : L_CS) + bcrow * SS_BC + (bcch & 15) * 16;
    const int cgx = tid & 7, xr0 = (tid >> 3) * 2, xcol = h * 64 + cgx * 8;
    u32x4 bcr[8], xin[5]; float dt0 = 0.f, dt1 = 0.f;
#define SSD_PREFETCH(cc) do { const int t0n = b * SEQ + (cc) * 128; \
        _Pragma("unroll") for (int j = 0; j < 8; ++j) bcr[j] = *(const u32x4*)(bcsrc + (size_t)((cc) * 128 + 16 * j) * 1024); \
        conv_load<2>(XBC, t0n, xr0, (cc) == 0, xcol, xin); \
        if (wid == 0) { dt0 = DT[(size_t)(t0n + 2 * lane) * NHS + h]; dt1 = DT[(size_t)(t0n + 2 * lane + 1) * NHS + h]; } } while (0)
    SSD_PREFETCH(0);
    for (int c = 0; c < 16; ++c) {
        const int t0 = b * SEQ + c * 128;
        if (wid == 0) {
            const float e0 = dt0 * Ah, e1 = dt1 * Ah; float sc = e0 + e1;
#pragma unroll
            for (int d = 1; d < 64; d <<= 1) { const float t = __shfl_up(sc, d); if (lane >= d) sc += t; }
            sm_dt[2 * lane] = dt0; sm_dt[2 * lane + 1] = dt1; sm_acs[2 * lane] = sc - e1; sm_acs[2 * lane + 1] = sc;
        }
#pragma unroll
        for (int j = 0; j < 8; ++j) *(LAS u32x4*)(bcdst + 16 * j * SS_BC) = bcr[j];
#pragma unroll
        for (int i = 0; i < 16; ++i) { const int p = 32 * pb + crow(i, hi), n = 32 * lb + r32; *(LAS bf16_t*)(lds + L_HS + p * SS_BC + n * 2) = (bf16_t)(cvtpk(hacc[i], 0.f) & 0xffffu); }
        __syncthreads();
        const float a_end = sm_acs[127];
        { float ov[2][8]; conv_apply<2>(xin, xcol, P.conv_w, P.conv_b, ov);
#pragma unroll
            for (int r = 0; r < 2; ++r) { const int l = xr0 + r; const float wl = sm_dt[l] * __expf(a_end - sm_acs[l]);
                u32x4 w; w.x = cvtpk(ov[r][0], ov[r][1]); w.y = cvtpk(ov[r][2], ov[r][3]); w.z = cvtpk(ov[r][4], ov[r][5]); w.w = cvtpk(ov[r][6], ov[r][7]);
                *(LAS u32x4*)(lds + L_XS + l * SS_X + cgx * 16) = w;
                w.x = cvtpk(ov[r][0] * wl, ov[r][1] * wl); w.y = cvtpk(ov[r][2] * wl, ov[r][3] * wl); w.z = cvtpk(ov[r][4] * wl, ov[r][5] * wl); w.w = cvtpk(ov[r][6] * wl, ov[r][7] * wl);
                *(LAS u32x4*)(lds + L_XW + l * SS_X + cgx * 16) = w; } }
        if (c + 1 < 16) SSD_PREFETCH(c + 1);
        __syncthreads();
        bf16x8 cf[8];
#pragma unroll
        for (int ks = 0; ks < 8; ++ks) cf[ks] = *(const LAS bf16x8*)(lds + L_CS + (32 * lb + r32) * SS_BC + (16 * ks + 8 * hi) * 2);
        f32x16 acc;
#pragma unroll
        for (int i = 0; i < 16; ++i) acc[i] = 0.f;
#pragma unroll
        for (int ks = 0; ks < 8; ++ks) { const bf16x8 a = *(const LAS bf16x8*)(lds + L_HS + (32 * pb + r32) * SS_BC + (16 * ks + 8 * hi) * 2); acc = MFMA32(a, cf[ks], acc); }
        const float acs_l = sm_acs[32 * lb + r32];
        { const float ea = __expf(acs_l);
#pragma unroll
          for (int i = 0; i < 16; ++i) acc[i] *= ea; }
        for (int sb = 0; sb <= lb; ++sb) {
            f32x16 st;
#pragma unroll
            for (int i = 0; i < 16; ++i) st[i] = 0.f;
#pragma unroll
            for (int ks = 0; ks < 8; ++ks) { const bf16x8 a = *(const LAS bf16x8*)(lds + L_BS + (32 * sb + r32) * SS_BC + (16 * ks + 8 * hi) * 2); st = MFMA32(a, cf[ks], st); }
            const int l = 32 * lb + r32;
#pragma unroll
            for (int i = 0; i < 16; ++i) { const int s = 32 * sb + crow(i, hi); float v = st[i] * __expf(acs_l - sm_acs[s]) * sm_dt[s]; v = (s <= l) ? v : 0.f; if (s == l) v += Dh; st[i] = v; }
#pragma unroll
            for (int k2 = 0; k2 < 2; ++k2) {
                u32x4 mw; mw.x = cvtpk(st[8 * k2 + 0], st[8 * k2 + 1]); mw.y = cvtpk(st[8 * k2 + 2], st[8 * k2 + 3]); mw.z = cvtpk(st[8 * k2 + 4], st[8 * k2 + 5]); mw.w = cvtpk(st[8 * k2 + 6], st[8 * k2 + 7]);
                const LAS unsigned char* xp = lds + L_XS + (32 * sb + 16 * k2 + 4 * hi + q4) * SS_X + (32 * pb + 16 * g1) * 2 + 8 * p4;
                const bf16x8 a = cat8(trrd(xp), trrd(xp + 8 * SS_X));
                acc = MFMA32(a, __builtin_bit_cast(bf16x8, mw), acc);
            }
        }
        {
            const size_t trow = (size_t)(t0 + 32 * lb + r32) * DIN + h * 64 + 32 * pb + 4 * hi;
#pragma unroll
            for (int g4 = 0; g4 < 4; ++g4) { bf16_t* zp = ZY + trow + 8 * g4; const u32x2 zw = *(const u32x2*)zp;
                u32x2 o; o.x = cvtpk(acc[4 * g4 + 0] * bflo(zw.x), acc[4 * g4 + 1] * bfhi(zw.x)); o.y = cvtpk(acc[4 * g4 + 2] * bflo(zw.y), acc[4 * g4 + 3] * bfhi(zw.y));
                if (dostore) *(u32x2*)zp = o; }
        }
        { const float ee = __expf(a_end);
#pragma unroll
          for (int i = 0; i < 16; ++i) hacc[i] *= ee; }
#pragma unroll
        for (int ks = 0; ks < 8; ++ks) {
            const LAS unsigned char* xp = lds + L_XW + (16 * ks + 8 * hi + q4) * SS_X + (32 * pb + 16 * g1) * 2 + 8 * p4;
            const LAS unsigned char* bp = lds + L_BS + (16 * ks + 8 * hi + q4) * SS_BC + (32 * lb + 16 * g1) * 2 + 8 * p4;
            const bf16x8 a = cat8(trrd(xp), trrd(xp + 4 * SS_X));
            const bf16x8 bb = cat8(trrd(bp), trrd(bp + 4 * SS_BC));
            hacc = MFMA32(a, bb, hacc);
        }
        __syncthreads();
    }
#undef SSD_PREFETCH
}

constexpr int AT_KS = 144, AT_VS = 288;
constexpr int LA_K = 0, LA_V = LA_K + 2 * 64 * AT_KS, LA_ST = LA_V + 2 * 64 * AT_VS, LA_END = LA_ST + 8 * 32 * 64 * 4;
static_assert(LA_END <= 131072 - 64, "attn lds");

DI void attn_unit(const Params& P, LAS unsigned char* lds, int b, int hh, int qb, float lam, bool dostore = true) {
    const int tid = otid(), lane = tid & 63, wid = __builtin_amdgcn_readfirstlane(tid >> 6), r32 = lane & 31, hi = lane >> 5;
    const int q4 = (lane & 15) >> 2, p4 = lane & 3, g1 = (lane >> 4) & 1;
    bf16_t* QKV = (bf16_t*)(P.ws + WS_R96);
    const size_t rowbase = (size_t)b * SEQ; const int q0 = qb * 256;
    const int qmin_w = q0 + wid * 32;
    const int ntile = (q0 + 256) / 64;
    LAS unsigned* stash = (LAS unsigned*)(lds + LA_ST) + wid * 2048 + lane;
    const int krow_ = tid >> 3, kch = tid & 7, vrow = tid >> 4, vch = tid & 15;
    for (int sub = 0; sub < 2; ++sub) {
        const bf16_t* Kg = QKV + rowbase * XBCW + DM + hh * 128 + sub * 64 + kch * 8;
        const bf16_t* Vg = QKV + rowbase * XBCW + 2 * DM + hh * 128 + vch * 8;
        bf16x8 qf[4];
        { const bf16_t* Qg = QKV + (rowbase + qmin_w + r32) * XBCW + hh * 128 + sub * 64 + hi * 8;
#pragma unroll
          for (int d0 = 0; d0 < 4; ++d0) qf[d0] = *(const bf16x8*)(Qg + d0 * 16); }
        float mrun = -1e30f, lrun = 0.f;
        f32x16 o[4];
#pragma unroll
        for (int e = 0; e < 4; ++e)
#pragma unroll
            for (int i = 0; i < 16; ++i) o[e][i] = 0.f;
        u32x4 kreg, vreg0, vreg1;
        kreg = *(const u32x4*)(Kg + (size_t)krow_ * XBCW); vreg0 = *(const u32x4*)(Vg + (size_t)vrow * XBCW); vreg1 = *(const u32x4*)(Vg + (size_t)(vrow + 32) * XBCW);
        for (int j = 0; j < ntile; ++j) {
            LAS unsigned char* Ks = lds + LA_K + (j & 1) * 64 * AT_KS; LAS unsigned char* Vs = lds + LA_V + (j & 1) * 64 * AT_VS;
            *(LAS u32x4*)(Ks + krow_ * AT_KS + kch * 16) = kreg;
            *(LAS u32x4*)(Vs + vrow * AT_VS + vch * 16) = vreg0; *(LAS u32x4*)(Vs + (vrow + 32) * AT_VS + vch * 16) = vreg1;
            __syncthreads();
            if (j + 1 < ntile) { const size_t ro = (size_t)(j + 1) * 64;
                kreg = *(const u32x4*)(Kg + (ro + krow_) * XBCW); vreg0 = *(const u32x4*)(Vg + (ro + vrow) * XBCW); vreg1 = *(const u32x4*)(Vg + (ro + vrow + 32) * XBCW); }
            if (64 * j <= qmin_w + 31) {
                f32x16 s0, s1;
#pragma unroll
                for (int i = 0; i < 16; ++i) { s0[i] = 0.f; s1[i] = 0.f; }
#pragma unroll
                for (int d0 = 0; d0 < 4; ++d0) {
                    const bf16x8 a0 = *(const LAS bf16x8*)(Ks + r32 * AT_KS + (d0 * 16 + hi * 8) * 2);
                    const bf16x8 a1 = *(const LAS bf16x8*)(Ks + (32 + r32) * AT_KS + (d0 * 16 + hi * 8) * 2);
                    s0 = MFMA32(a0, qf[d0], s0); s1 = MFMA32(a1, qf[d0], s1);
                }
                if (64 * j + 63 > qmin_w) {
                    const int qg = qmin_w + r32;
#pragma unroll
                    for (int i = 0; i < 16; ++i) { const int kv = 64 * j + crow(i, hi); if (kv > qg) s0[i] = -INFINITY; if (kv + 32 > qg) s1[i] = -INFINITY; }
                }
                float mx = s0[0];
#pragma unroll
                for (int i = 1; i < 16; ++i) mx = fmaxf(mx, s0[i]);
#pragma unroll
                for (int i = 0; i < 16; ++i) mx = fmaxf(mx, s1[i]);
                mx = fmaxf(mx, __shfl_xor(mx, 32));
                const float mnew = fmaxf(mrun, mx); const float alpha = exp2f(mrun - mnew); mrun = mnew;
                float rs = 0.f;
#pragma unroll
                for (int i = 0; i < 16; ++i) { s0[i] = exp2f(s0[i] - mnew); s1[i] = exp2f(s1[i] - mnew); rs += s0[i] + s1[i]; }
                lrun = lrun * alpha + rs;
#pragma unroll
                for (int e = 0; e < 4; ++e)
#pragma unroll
                    for (int i = 0; i < 16; ++i) o[e][i] *= alpha;
                bf16x8 pf[2][2];
#pragma unroll
                for (int k2 = 0; k2 < 2; ++k2) {
                    u32x4 w; w.x = cvtpk(s0[8 * k2 + 0], s0[8 * k2 + 1]); w.y = cvtpk(s0[8 * k2 + 2], s0[8 * k2 + 3]); w.z = cvtpk(s0[8 * k2 + 4], s0[8 * k2 + 5]); w.w = cvtpk(s0[8 * k2 + 6], s0[8 * k2 + 7]);
                    pf[0][k2] = __builtin_bit_cast(bf16x8, w);
                    w.x = cvtpk(s1[8 * k2 + 0], s1[8 * k2 + 1]); w.y = cvtpk(s1[8 * k2 + 2], s1[8 * k2 + 3]); w.z = cvtpk(s1[8 * k2 + 4], s1[8 * k2 + 5]); w.w = cvtpk(s1[8 * k2 + 6], s1[8 * k2 + 7]);
                    pf[1][k2] = __builtin_bit_cast(bf16x8, w);
                }
#pragma unroll
                for (int e = 0; e < 4; ++e)
#pragma unroll
                    for (int blk = 0; blk < 2; ++blk)
#pragma unroll
                        for (int k2 = 0; k2 < 2; ++k2) {
                            const LAS unsigned char* vp = Vs + (32 * blk + 16 * k2 + 4 * hi + q4) * AT_VS + (32 * e + 16 * g1) * 2 + 8 * p4;
                            const bf16x8 a = cat8(trrd(vp), trrd(vp + 8 * AT_VS));
                            o[e] = MFMA32(a, pf[blk][k2], o[e]);
                            if (k2 == 1) __builtin_amdgcn_sched_barrier(0);
                        }
            }
        }
        const float ltot = lrun + __shfl_xor(lrun, 32); const float inv = 1.f / ltot;
        if (sub == 0) {
#pragma unroll
            for (int e = 0; e < 4; ++e)
#pragma unroll
                for (int k = 0; k < 8; ++k) stash[(e * 8 + k) * 64] = cvtpk(o[e][2 * k] * inv, o[e][2 * k + 1] * inv);
        } else {
            float ss = 0.f;
#pragma unroll
            for (int e = 0; e < 4; ++e)
#pragma unroll
                for (int k = 0; k < 8; ++k) { const unsigned w = stash[(e * 8 + k) * 64];
                    const float v0 = bflo(w) - lam * (o[e][2 * k] * inv), v1 = bfhi(w) - lam * (o[e][2 * k + 1] * inv);
                    o[e][2 * k] = v0; o[e][2 * k + 1] = v1; ss += v0 * v0 + v1 * v1; }
            ss += __shfl_xor(ss, 32);
            const float rstd = rsqrtf(ss * (1.f / 128.f) + EPS) * (1.f - LAM_INIT);
            bf16_t* Og = QKV + (rowbase + qmin_w + r32) * XBCW + hh * 128 + 4 * hi;
#pragma unroll
            for (int e = 0; e < 4; ++e)
#pragma unroll
                for (int g4 = 0; g4 < 4; ++g4) { const int ec = 32 * e + 8 * g4 + 4 * hi; const f32x4 sw = *(const f32x4*)(P.subln_w + ec);
                    u32x2 w; w.x = cvtpk(o[e][4 * g4 + 0] * rstd * sw.x, o[e][4 * g4 + 1] * rstd * sw.y); w.y = cvtpk(o[e][4 * g4 + 2] * rstd * sw.z, o[e][4 * g4 + 3] * rstd * sw.w);
                    if (dostore) *(u32x2*)(Og + 32 * e + 8 * g4) = w; }
        }
        __syncthreads();
    }
}

DI void ynorm_row(bf16_t* yrow, int lane) {
    u32x4* p = (u32x4*)yrow + lane * 4; u32x4 v[4]; float ss = 0.f;
#pragma unroll
    for (int j = 0; j < 4; ++j) { v[j] = p[j];
        const float a0 = bflo(v[j].x), a1 = bfhi(v[j].x), a2 = bflo(v[j].y), a3 = bfhi(v[j].y), a4 = bflo(v[j].z), a5 = bfhi(v[j].z), a6 = bflo(v[j].w), a7 = bfhi(v[j].w);
        ss += (a0 * a0 + a1 * a1) + (a2 * a2 + a3 * a3) + (a4 * a4 + a5 * a5) + (a6 * a6 + a7 * a7); }
    ss += __shfl_xor(ss, 1); ss += __shfl_xor(ss, 2); ss += __shfl_xor(ss, 4); ss += __shfl_xor(ss, 8);
    const float r = rsqrtf(ss * (1.f / 512.f) + EPS);
#pragma unroll
    for (int j = 0; j < 4; ++j) { u32x4 o;
        o.x = cvtpk(bflo(v[j].x) * r, bfhi(v[j].x) * r); o.y = cvtpk(bflo(v[j].y) * r, bfhi(v[j].y) * r); o.z = cvtpk(bflo(v[j].z) * r, bfhi(v[j].z) * r); o.w = cvtpk(bflo(v[j].w) * r, bfhi(v[j].w) * r);
        p[j] = o; }
}

DI void row_pass5(const float* mixed, const float* x, const float* w1, const float* w2, float* out, bf16_t* h2, int lane) {
    const f32x4* mr = (const f32x4*)mixed + lane; const f32x4* xr = (const f32x4*)x + lane;
    f32x4 v[4]; float s = 0.f;
#pragma unroll
    for (int j = 0; j < 4; ++j) { v[j] = mr[64 * j]; s += (v[j].x * v[j].x + v[j].y * v[j].y) + (v[j].z * v[j].z + v[j].w * v[j].w); }
    const float rstd = rsqrtf(wave_sum(s) * (1.f / DM) + EPS);
    float s2 = 0.f;
#pragma unroll
    for (int j = 0; j < 4; ++j) { const f32x4 g = ((const f32x4*)w1 + lane)[64 * j]; v[j] = xr[64 * j] + v[j] * rstd * g; ((f32x4*)out + lane)[64 * j] = v[j];
        s2 += (v[j].x * v[j].x + v[j].y * v[j].y) + (v[j].z * v[j].z + v[j].w * v[j].w); }
    const float rstd2 = rsqrtf(wave_sum(s2) * (1.f / DM) + EPS);
    u32x2* o8 = (u32x2*)h2 + lane;
#pragma unroll
    for (int j = 0; j < 4; ++j) { const f32x4 g = ((const f32x4*)w2 + lane)[64 * j]; u32x2 o; o.x = cvtpk(v[j].x * rstd2 * g.x, v[j].y * rstd2 * g.y); o.y = cvtpk(v[j].z * rstd2 * g.z, v[j].w * rstd2 * g.w); o8[64 * j] = o; }
}
DI void row_pass8(const float* f, const float* w, float* out, int lane) {
    const f32x4* fr_ = (const f32x4*)f + lane;
    f32x4 v[4]; float s = 0.f;
#pragma unroll
    for (int j = 0; j < 4; ++j) { v[j] = fr_[64 * j]; s += (v[j].x * v[j].x + v[j].y * v[j].y) + (v[j].z * v[j].z + v[j].w * v[j].w); }
    const float rstd = rsqrtf(wave_sum(s) * (1.f / DM) + EPS);
#pragma unroll
    for (int j = 0; j < 4; ++j) { const f32x4 g = ((const f32x4*)w + lane)[64 * j]; f32x4* op = (f32x4*)out + lane + 64 * j; *op = *op + v[j] * rstd * g; }
}


#define XB_TMO      128
#define XB_XCNT(j)  (256  + 64 * (j))
#define XB_XSUB(j)  (1280 + 64 * (j))
#define XB_XGEN(j)  (2304 + 64 * (j))
#define XB_TOP      3328
#define XB_TOPGEN   3392
#define XCD_BAR_WORDS 3456
#define XB_SPIN_CAP (1u << 22)
DI unsigned xb_ld(unsigned* p)              { return __hip_atomic_load(p, __ATOMIC_RELAXED, __HIP_MEMORY_SCOPE_AGENT); }
DI unsigned xb_add(unsigned* p, unsigned v) { return __hip_atomic_fetch_add(p, v, __ATOMIC_RELAXED, __HIP_MEMORY_SCOPE_AGENT); }
DI unsigned xb_xcc_id() { return (unsigned)__builtin_amdgcn_s_getreg((3 << 11) | 20) & 0xFu; }
#define XB_SPIN(cond, bar) do { unsigned _sp = 0; while (cond) { __builtin_amdgcn_s_sleep(1); \
    if ((++_sp & 255u) == 0u) { if (xb_ld(&(bar)[XB_TMO])) break; if (_sp > XB_SPIN_CAP) { atomicAdd(&(bar)[XB_TMO], 1u); break; } } } } while (0)
struct XcdBarrier { unsigned* bar; unsigned x; volatile LAS unsigned* st; };
DI XcdBarrier xcd_barrier_post(unsigned* bar, volatile LAS unsigned* st) {
    XcdBarrier b; b.bar = bar; b.x = xb_xcc_id(); b.st = st;
    if (threadIdx.x == 0) (void)xb_add(&bar[XB_XCNT(b.x)], 1u);
    return b;
}
DI void xcd_barrier_complete(unsigned* bar, unsigned x, unsigned& nloc, unsigned& nx) {
    const unsigned G = gridDim.x * gridDim.y * gridDim.z;
    unsigned sum, cnt, mine, sp = 0u;
    for (;;) {
        sum = 0u; cnt = 0u; mine = 0u;
#pragma unroll
        for (unsigned j = 0; j < 16; ++j) { const unsigned c = xb_ld(&bar[XB_XCNT(j)]); sum += c; cnt += (c > 0u) ? 1u : 0u; mine = (j == x) ? c : mine; }
        if (sum == G) break;
        __builtin_amdgcn_s_sleep(1);
        if ((++sp & 255u) == 0u) { if (xb_ld(&bar[XB_TMO])) break; if (sp > XB_SPIN_CAP) { atomicAdd(&bar[XB_TMO], 1u); break; } }
    }
    nloc = mine > 0u ? mine : 1u; nx = cnt > 0u ? cnt : 1u;
}
DI void xcd_barrier(const XcdBarrier& b) {
    asm volatile("s_waitcnt vmcnt(0)" ::: "memory");
    __syncthreads();
    if (threadIdx.x == 0) {
        unsigned* bar = b.bar;
        __builtin_amdgcn_s_waitcnt(0);
        unsigned nloc = b.st[0], nx = b.st[1];
        if (nloc == 0u) { xcd_barrier_complete(bar, b.x, nloc, nx); b.st[0] = nloc; b.st[1] = nx; }
        const unsigned old = xb_add(&bar[XB_XSUB(b.x)], 1u);
        const unsigned gen = old / nloc;
        if (old + 1u == (gen + 1u) * nloc) {
            __builtin_amdgcn_fence(__ATOMIC_RELEASE, "agent");
            asm volatile("s_waitcnt vmcnt(0)" ::: "memory");
            const unsigned og = xb_add(&bar[XB_TOP], 1u);
            const unsigned tg = og / nx;
            if (og + 1u == (tg + 1u) * nx) xb_add(&bar[XB_TOPGEN], 1u);
            else XB_SPIN(xb_ld(&bar[XB_TOPGEN]) == tg, bar);
            __builtin_amdgcn_fence(__ATOMIC_ACQUIRE, "agent");
            xb_add(&bar[XB_XGEN(b.x)], 1u);
            asm volatile("s_waitcnt vmcnt(0)" ::: "memory");
        } else {
            XB_SPIN(xb_ld(&bar[XB_XGEN(b.x)]) == gen, bar);
            __builtin_amdgcn_fence(__ATOMIC_ACQUIRE, "agent");
            asm volatile("s_waitcnt vmcnt(0)" ::: "memory");
        }
    }
    __syncthreads();
}

__global__ void __launch_bounds__(512, 2) hybrid_fwd(Params P) {
    extern __shared__ __attribute__((aligned(16))) unsigned char lds_raw[];
    LAS unsigned char* lds = (LAS unsigned char*)lds_raw;
    cg::grid_group grid = cg::this_grid();
    const int G = gridDim.x, NGW = G * 8;
#define PHASE_IDS const int tid = otid(), lane = tid & 63, wave = tid >> 6, gw = blockIdx.x * 8 + wave; (void)tid; (void)lane; (void)wave; (void)gw
    unsigned char* ws = P.ws;
    bf16_t* ZY = (bf16_t*)(ws + WS_ZY); bf16_t* R96 = (bf16_t*)(ws + WS_R96); bf16_t* XN = (bf16_t*)(ws + WS_XN);
    const bf16_t* Win = (const bf16_t*)(ws + WS_WIN); const bf16_t* Wssm = (const bf16_t*)(ws + WS_WSSM); const bf16_t* Watt = (const bf16_t*)(ws + WS_WATT);
    const bf16_t* Wmix = (const bf16_t*)(ws + WS_WMIX); const bf16_t* Wgu = (const bf16_t*)(ws + WS_WGU); const bf16_t* Wdn = (const bf16_t*)(ws + WS_WDN);
    float* DT = (float*)(ws + WS_DT); const float* ROPE = (const float*)(ws + WS_ROPE);
    bf16_t* GATES = (bf16_t*)P.out;
    float* F32 = (float*)(ws + WS_ZY);

    p0_prologue(P, lds, G);
#ifdef PROBE_P0
    __syncthreads(); p0_prologue(P, lds, G);
#endif
    { unsigned* bw = (unsigned*)(ws + WS_BAR); if (blockIdx.x == 0) for (int i = otid(); i < XCD_BAR_WORDS; i += 512) bw[i] = 0u;
      if (otid() < 2) ((volatile LAS unsigned*)(lds + 131072 + 64))[otid()] = 0u; }
    grid.sync();
    const XcdBarrier xbar = xcd_barrier_post((unsigned*)(ws + WS_BAR), (volatile LAS unsigned*)(lds + 131072 + 64));
#define GRID_BAR() xcd_barrier(xbar)
#ifdef PROBE_SYNC
    for (int i = 0; i < 10; ++i) GRID_BAR();
#endif
    { pg8::Gemm g{XN, Win, T_TOK, N1A, DM, DM}; pg8::StaticOrder S; S.init(T_TOK, N1A, G, (int)blockIdx.x);
      EpiP1a E{ZY, R96, DT, P.dt_bias};
      pg8::gemm_phase<EpiP1a, pg8::StaticOrder, true, true>(lds, g, S, E); }
    GRID_BAR();
    p1c_prepass(P, G);
    GRID_BAR();
#ifdef PROBE_SSD
    { const int one = oone(); for (int rep = 0; rep < 2; ++rep) for (int u = blockIdx.x; u < NB * NHS; u += G) ssd_unit(P, lds, u >> 5, u & 31, rep == one); }
#else
    for (int u = blockIdx.x; u < NB * NHS; u += G) ssd_unit(P, lds, u >> 5, u & 31);
#endif
    GRID_BAR();
    { pg8::Gemm g{XN, Win + (size_t)N1B_ROW0 * DM, T_TOK, N1B, DM, DM}; pg8::StaticOrder S; S.init(T_TOK, N1B, G, (int)blockIdx.x);
      EpiP1b E{R96, GATES, ROPE};
      pg8::gemm_phase<EpiP1b, pg8::StaticOrder, true, true>(lds, g, S, E); }
    GRID_BAR();
    {
        PHASE_IDS;
        LAS float* lamp = (LAS float*)(lds + 131072);
        if (wave == 0) { const float a = wave_sum(P.lq1[lane] * P.lk1[lane]), c = wave_sum(P.lq2[lane] * P.lk2[lane]); if (lane == 0) lamp[0] = expf(a) - expf(c) + LAM_INIT; }
        __syncthreads();
        const float lam = lamp[0];
#ifdef PROBE_ATT
        { const int one = oone(); for (int rep = 0; rep < 2; ++rep) for (int it = blockIdx.x; it < 256; it += G) {
            const int bh = it >> 2, s = it & 3;
            attn_unit(P, lds, bh >> 3, bh & 7, 7 - s, lam, rep == one);
            attn_unit(P, lds, bh >> 3, bh & 7, s, lam, rep == one);
        } }
#else
        for (int it = blockIdx.x; it < 256; it += G) {
            const int bh = it >> 2, s = it & 3;
            attn_unit(P, lds, bh >> 3, bh & 7, 7 - s, lam);
            attn_unit(P, lds, bh >> 3, bh & 7, s, lam);
        }
#endif
        for (int m = gw; m < T_TOK; m += NGW) ynorm_row(ZY + (size_t)m * DIN, lane);
    }
    GRID_BAR();
    { bf16_t* MIXIN = XN;
      { pg8::Gemm g{ZY, Wssm, T_TOK, DM, DIN, DIN}; pg8::StaticOrder S; S.init(T_TOK, DM, G, (int)blockIdx.x); EpiSsmOut E{MIXIN, GATES};
        pg8::gemm_phase<EpiSsmOut, pg8::StaticOrder, true, true>(lds, g, S, E); }
      { pg8::Gemm g{R96, Watt, T_TOK, DM, DM, XBCW}; pg8::StaticOrder S; S.init(T_TOK, DM, G, (int)blockIdx.x); EpiAttOut E{MIXIN, GATES};
        pg8::gemm_phase<EpiAttOut, pg8::StaticOrder, true, true>(lds, g, S, E); } }
    GRID_BAR();
    { pg8::Gemm g{XN, Wmix, T_TOK, DM, DM, DM}; pg8::StaticOrder S; S.init(T_TOK, DM, G, (int)blockIdx.x); EpiF32 E{F32};
      pg8::gemm_phase<EpiF32, pg8::StaticOrder, true, true>(lds, g, S, E); }
    GRID_BAR();
    { PHASE_IDS;
    for (int m = gw; m < T_TOK; m += NGW) row_pass5(F32 + (size_t)m * DM, P.x + (size_t)m * DM, P.n_post_mix, P.n_pre_ffn, P.out + (size_t)m * DM, XN + (size_t)m * DM, lane); }
    GRID_BAR();
    { pg8::Gemm g{XN, Wgu, T_TOK, 2 * FFH, DM, DM}; pg8::StaticOrder S; S.init(T_TOK, 2 * FFH, G, (int)blockIdx.x); EpiSwiglu E{R96};
      pg8::gemm_phase<EpiSwiglu, pg8::StaticOrder, true, true>(lds, g, S, E); }
    GRID_BAR();
    { pg8::Gemm g{R96, Wdn, T_TOK, DM, FFH, FFH}; pg8::StaticOrder S; S.init(T_TOK, DM, G, (int)blockIdx.x); EpiF32 E{F32};
      pg8::gemm_phase<EpiF32, pg8::StaticOrder, true, true>(lds, g, S, E); }
    GRID_BAR();
    { PHASE_IDS;
    for (int m = gw; m < T_TOK; m += NGW) row_pass8(F32 + (size_t)m * DM, P.n_post_ffn, P.out + (size_t)m * DM, lane); }
}

extern "C" void kernel_launch(void* const* d_in, const int* in_sizes, int n_in, void* d_out, int out_size, void* d_ws, size_t ws_size, hipStream_t stream) {
    static int grid = 0;
    if (grid == 0) {
        if (n_in != 24 || out_size != T_TOK * DM || ws_size < WS_END) { fprintf(stderr, "kernel_launch: unexpected shapes (n_in %d out %d ws %zu)\n", n_in, out_size, ws_size); grid = -1; return; }
        int dev = 0, cus = 0, per_cu = 0;
        hipGetDevice(&dev); hipDeviceGetAttribute(&cus, hipDeviceAttributeMultiprocessorCount, dev);
        hipFuncSetAttribute((const void*)hybrid_fwd, hipFuncAttributeMaxDynamicSharedMemorySize, LDS_BYTES);
        hipOccupancyMaxActiveBlocksPerMultiprocessor(&per_cu, (const void*)hybrid_fwd, 512, LDS_BYTES);
        if (per_cu < 1) { fprintf(stderr, "kernel_launch: occupancy query says %d blocks/CU\n", per_cu); per_cu = 1; }
        (void)hipGetLastError();
        grid = cus * 1;
    }
    if (grid < 0) return;
    Params p{};
    p.x = (const float*)d_in[0]; p.pos = (const int*)d_in[1]; p.w_in = (const float*)d_in[2]; p.conv_w = (const float*)d_in[3]; p.conv_b = (const float*)d_in[4];
    p.dt_bias = (const float*)d_in[5]; p.a_log = (const float*)d_in[6]; p.d_skip = (const float*)d_in[7]; p.ssm_norm_w = (const float*)d_in[8]; p.w_ssm_out = (const float*)d_in[9];
    p.lq1 = (const float*)d_in[10]; p.lk1 = (const float*)d_in[11]; p.lq2 = (const float*)d_in[12]; p.lk2 = (const float*)d_in[13]; p.subln_w = (const float*)d_in[14];
    p.w_attn_out = (const float*)d_in[15]; p.w_mix = (const float*)d_in[16]; p.n_pre_mix = (const float*)d_in[17]; p.n_post_mix = (const float*)d_in[18];
    p.n_pre_ffn = (const float*)d_in[19]; p.n_post_ffn = (const float*)d_in[20]; p.w_gate = (const float*)d_in[21]; p.w_up = (const float*)d_in[22]; p.w_down = (const float*)d_in[23];
    p.out = (float*)d_out; p.ws = (unsigned char*)d_ws;
    void* args[] = {&p};
    hipError_t e = hipLaunchCooperativeKernel((const void*)hybrid_fwd, dim3(grid), dim3(512), args, LDS_BYTES, stream);
    if (e != hipSuccess) fprintf(stderr, "cooperative launch failed: %s (grid %d)\n", hipGetErrorString(e), grid);
}
```

```cpp
#include <hip/hip_runtime.h>
#include <hip/hip_cooperative_groups.h>
#include <cstdio>
#include <cstdint>
namespace cg = cooperative_groups;

#define LAS __attribute__((address_space(3)))
typedef unsigned short bf16_t;
typedef short bf16x8 __attribute__((ext_vector_type(8)));
typedef short s16x4 __attribute__((ext_vector_type(4)));
typedef float f32x4 __attribute__((ext_vector_type(4)));
typedef float f32x16 __attribute__((ext_vector_type(16)));
typedef unsigned u32x4 __attribute__((ext_vector_type(4)));
typedef unsigned u32x2 __attribute__((ext_vector_type(2)));
typedef float f32x2_t __attribute__((ext_vector_type(2)));
typedef __bf16 bf16x2_t __attribute__((ext_vector_type(2)));
#define DI __device__ __forceinline__

DI int otid() { int t = threadIdx.x; asm volatile("" : "+v"(t)); return t; }
DI int oone() { int t = 1; asm volatile("" : "+s"(t)); return t; }
DI unsigned cvtpk(float lo, float hi) { f32x2_t v = {lo, hi}; bf16x2_t b = __builtin_convertvector(v, bf16x2_t); return __builtin_bit_cast(unsigned, b); }
DI float bflo(unsigned w) { return __uint_as_float(w << 16); }
DI float bfhi(unsigned w) { return __uint_as_float(w & 0xffff0000u); }
DI float silu_f(float x) { return x / (1.f + __expf(-x)); }
DI float sigmoid_f(float x) { return 1.f / (1.f + __expf(-x)); }

constexpr int T_TOK = 16384, SEQ = 2048, DM = 1024, NB = 8;
constexpr int NHS = 32, DIN = 2048, XBCW = 3072, FFH = 2816;
constexpr int N1A = 5120, N1B = 5120, N1B_ROW0 = 5376;
constexpr float EPS = 1e-6f;
constexpr float QSCALE = 0.125f * 1.4426950408889634f;
constexpr float LAM_INIT = 0.2f;

constexpr size_t MiB = 1u << 20;
constexpr size_t WS_ZY = 0, WS_R96 = 64 * MiB, WS_XN = 160 * MiB, WS_WIN = 192 * MiB, WS_WSSM = 213 * MiB, WS_WATT = 217 * MiB, WS_WMIX = 219 * MiB,
                 WS_WGU = 221 * MiB, WS_WDN = 232 * MiB, WS_DT = 238 * MiB, WS_ROPE = 240 * MiB, WS_BAR = 241 * MiB, WS_END = 242 * MiB;
constexpr int LDS_BYTES = 147456;

struct Params {
    const float* x; const int* pos; const float* w_in; const float* conv_w; const float* conv_b; const float* dt_bias; const float* a_log; const float* d_skip;
    const float* ssm_norm_w; const float* w_ssm_out; const float* lq1; const float* lk1; const float* lq2; const float* lk2; const float* subln_w; const float* w_attn_out;
    const float* w_mix; const float* n_pre_mix; const float* n_post_mix; const float* n_pre_ffn; const float* n_post_ffn; const float* w_gate; const float* w_up; const float* w_down;
    float* out; unsigned char* ws;
};

namespace pg8 {
#define PG8_LAS __attribute__((address_space(3)))
constexpr int BM = 256, BK = 64, HALF = 128, HTB = HALF * BK * 2, STAGE_BYTES = 8 * HTB, NXCD = 8, WGM = 8;
__host__ __device__ __forceinline__ int lds_byte(int r, int c) { const int st = (r >> 4) * 2 + (c >> 5), rr = r & 15, cc = c & 31, ob = rr * 64 + cc * 2; return st * 1024 + (ob ^ (((ob >> 9) & 1) << 5)); }
__host__ __device__ __forceinline__ void stage_rc(int b, int& R, int& C) { const int st = b / 1024, sb = b % 1024, swz = sb ^ (((sb >> 9) & 1) << 5); R = (st >> 1) * 16 + swz / 64; C = (st & 1) * 32 + (swz % 64) / 2; }
__host__ __device__ __forceinline__ int perm32(int rho) { const int n = rho >> 4, i = rho & 15; return 8 * (i >> 2) + 4 * n + (i & 3); }
struct Unit { int pm, pn; };
struct Gemm { const bf16_t* A; const bf16_t* Bt; int M, N, K, lda; };
struct StaticOrder {
    int nM, nN, nwg, G, c;
    __host__ __device__ void init(int M, int N, int G_, int c_) { nM = M / BM; nN = N / BM; nwg = nM * nN; G = G_; c = c_; }
    __host__ __device__ bool next(int i, Unit& u) const {
        const long L = (long)i * G + c; if (L >= nwg) return false;
        int wgid = (int)L; { const int q = nwg / NXCD, r = nwg % NXCD, xcd = wgid % NXCD, off = wgid / NXCD; wgid = (xcd < r ? xcd * (q + 1) : r * (q + 1) + (xcd - r) * q) + off; }
        const int nig = WGM * nN, gid = wgid / nig, fm = gid * WGM, gsz = (nM - fm) < WGM ? (nM - fm) : WGM;
        u.pm = fm + ((wgid % nig) % gsz); u.pn = (wgid % nig) / gsz; return true;
    }
};
template <class Epi, class Sched, bool ALIGN_EPI, bool SP2>
__device__ __forceinline__ void gemm_phase(PG8_LAS unsigned char* lds, const Gemm g, const Sched& S, const Epi& E) {
    const int tid = otid(), wid = __builtin_amdgcn_readfirstlane(tid >> 6), lane = tid & 63, wr = wid >> 2, wc = wid & 3, fr = lane & 15, fq = lane >> 4;
    const int K = g.K, nt = K / BK, lda = g.lda;
    unsigned voffA[2], voffB[2];
#pragma unroll
    for (int i = 0; i < 2; ++i) { int R, C; stage_rc(tid * 16 + i * 8192, R, C); const int Rb = Epi::PERM ? ((R & ~31) + perm32(R & 31)) : R;
        voffA[i] = (unsigned)(R * lda + C) * 2u; voffB[i] = (unsigned)(Rb * K + C) * 2u; }
    const size_t kstep = (size_t)(BK * 2);
    const size_t hstepA = (size_t)HALF * lda * 2, hstepB = (size_t)HALF * K * 2;
    const size_t tstepA = 2 * hstepA, tstepB = 2 * hstepB;
    const unsigned ldsw = (unsigned)wid * 1024u;
    const int aoff = lds_byte(wr * 64 + fr, fq * 8), boff = lds_byte(wc * 32 + fr, fq * 8);
#define PG8_SA(b, h) (((b) * 2 + (h)) * HTB)
#define PG8_SB(b, h) ((4 + (b) * 2 + (h)) * HTB)
#define PG8_STAGE(bufoff, gbase, voff) do { _Pragma("unroll") for (int _i = 0; _i < 2; ++_i) \
        __builtin_amdgcn_global_load_lds((const unsigned*)((const char*)(gbase) + (voff)[_i]), (PG8_LAS unsigned*)(lds + (bufoff) + ldsw + _i * 8192), 16, 0, 0); } while (0)
#define PG8_LDA(dst, b, h) do { _Pragma("unroll") for (int m = 0; m < 4; ++m) _Pragma("unroll") for (int k = 0; k < 2; ++k) dst[m][k] = *(const PG8_LAS bf16x8*)(lds + PG8_SA(b, h) + aoff + m * 2048 + k * 1024); } while (0)
#define PG8_LDB(dst, b, h) do { _Pragma("unroll") for (int n = 0; n < 2; ++n) _Pragma("unroll") for (int k = 0; k < 2; ++k) dst[n][k] = *(const PG8_LAS bf16x8*)(lds + PG8_SB(b, h) + boff + n * 2048 + k * 1024); } while (0)
#define PG8_MMA(ai, bj, At, Bt) do { __builtin_amdgcn_s_setprio(1); _Pragma("unroll") for (int m = 0; m < 4; ++m) _Pragma("unroll") for (int n = 0; n < 2; ++n) _Pragma("unroll") for (int k = 0; k < 2; ++k) \
        acc[ai][bj][m][n] = __builtin_amdgcn_mfma_f32_16x16x32_bf16(Bt[n][k], At[m][k], acc[ai][bj][m][n], 0, 0, 0); __builtin_amdgcn_s_setprio(0); } while (0)
#define PG8_WAIT_V(n) asm volatile("s_waitcnt vmcnt(" #n ")" ::: "memory")
#define PG8_WAIT_L(n) asm volatile("s_waitcnt lgkmcnt(" #n ")" ::: "memory")
#define PG8_BAR __builtin_amdgcn_s_barrier()
#define PG8_SCHED __builtin_amdgcn_sched_barrier(0)
    Unit cur, nxt; int ui = 0;
    if (!S.next(0, cur)) return;
    f32x4 acc[2][2][4][2];
#pragma unroll
    for (int a = 0; a < 2; ++a)
#pragma unroll
        for (int b = 0; b < 2; ++b)
#pragma unroll
            for (int m = 0; m < 4; ++m)
#pragma unroll
                for (int n = 0; n < 2; ++n) acc[a][b][m][n] = (f32x4){0.f, 0.f, 0.f, 0.f};
    bf16x8 At[4][2], B0[2][2], B1[2][2];
    const char* cA = (const char*)g.A + (size_t)cur.pm * tstepA; const char* cB = (const char*)g.Bt + (size_t)cur.pn * tstepB;
    if constexpr (SP2) {
        PG8_STAGE(PG8_SB(0, 0), cB, voffB); PG8_STAGE(PG8_SB(0, 1), cB + hstepB, voffB); PG8_STAGE(PG8_SA(0, 0), cA, voffA); PG8_STAGE(PG8_SA(0, 1), cA + hstepA, voffA);
        if (wr == 1) PG8_BAR;
        PG8_WAIT_V(2); PG8_BAR;
        PG8_STAGE(PG8_SB(1, 0), cB + kstep, voffB); PG8_STAGE(PG8_SA(1, 0), cA + kstep, voffA); PG8_STAGE(PG8_SB(1, 1), cB + hstepB + kstep, voffB);
        PG8_WAIT_V(6); PG8_BAR;
    }
    for (;;) {
        const bool has_next = S.next(ui + 1, nxt);
        const char* nA = has_next ? (const char*)g.A + (size_t)nxt.pm * tstepA : cA; const char* nB = has_next ? (const char*)g.Bt + (size_t)nxt.pn * tstepB : cB;
        for (int t = 0; t < nt; t += 2) {
            const bool last = (t == nt - 2);
            const char* a1 = cA + (size_t)(t + 1) * kstep;
            const char* a2 = last ? nA : cA + (size_t)(t + 2) * kstep; const char* b2 = last ? nB : cB + (size_t)(t + 2) * kstep;
            const char* a3 = a2 + kstep; const char* b3 = b2 + kstep;
            PG8_LDB(B0, 0, 0); PG8_LDB(B1, 0, 1); PG8_SCHED; PG8_LDA(At, 0, 0); PG8_STAGE(PG8_SA(1, 1), a1 + hstepA, voffA);
            PG8_WAIT_V(8); PG8_WAIT_L(0); PG8_BAR; PG8_MMA(0, 0, At, B0); PG8_MMA(0, 1, At, B1); PG8_BAR; PG8_SCHED;
            PG8_LDA(At, 0, 1); PG8_STAGE(PG8_SB(0, 0), b2, voffB); PG8_STAGE(PG8_SB(0, 1), b2 + hstepB, voffB); PG8_STAGE(PG8_SA(0, 0), a2, voffA);
            PG8_WAIT_V(8); PG8_WAIT_L(0); PG8_BAR; PG8_MMA(1, 0, At, B0); PG8_MMA(1, 1, At, B1); PG8_BAR; PG8_SCHED;
            PG8_LDB(B0, 1, 0); PG8_LDB(B1, 1, 1); PG8_SCHED; PG8_LDA(At, 1, 0); PG8_STAGE(PG8_SA(0, 1), a2 + hstepA, voffA);
            PG8_WAIT_V(8); PG8_WAIT_L(0); PG8_BAR; PG8_MMA(0, 0, At, B0); PG8_MMA(0, 1, At, B1); PG8_BAR; PG8_SCHED;
            PG8_LDA(At, 1, 1); PG8_STAGE(PG8_SB(1, 0), b3, voffB); PG8_STAGE(PG8_SB(1, 1), b3 + hstepB, voffB); PG8_STAGE(PG8_SA(1, 0), a3, voffA);
            PG8_WAIT_V(8); PG8_WAIT_L(0); PG8_BAR; PG8_MMA(1, 0, At, B0); PG8_MMA(1, 1, At, B1); PG8_BAR; PG8_SCHED;
        }
        if constexpr (ALIGN_EPI) { if (wr == 0) PG8_BAR; }
        E(acc, cur, wr, wc, fr, fq);
        if (!has_next) break;
#pragma unroll
        for (int a = 0; a < 2; ++a)
#pragma unroll
            for (int b = 0; b < 2; ++b)
#pragma unroll
                for (int m = 0; m < 4; ++m)
#pragma unroll
                    for (int n = 0; n < 2; ++n) acc[a][b][m][n] = (f32x4){0.f, 0.f, 0.f, 0.f};
        cur = nxt; cA = nA; cB = nB; ++ui;
        if constexpr (ALIGN_EPI) { if (wr == 1) PG8_BAR; }
    }
    PG8_WAIT_V(0);
    if constexpr (!ALIGN_EPI) { if (wr == 0) PG8_BAR; }
    PG8_BAR;
#undef PG8_SA
#undef PG8_SB
#undef PG8_STAGE
#undef PG8_LDA
#undef PG8_LDB
#undef PG8_MMA
#undef PG8_WAIT_V
#undef PG8_WAIT_L
#undef PG8_BAR
#undef PG8_SCHED
}
}
using pg8::Unit;
typedef const f32x4 (&AccRef)[2][2][4][2];

DI void st8(bf16_t* p, f32x4 v0, f32x4 v1) { u32x4 w; w.x = cvtpk(v0[0], v0[1]); w.y = cvtpk(v0[2], v0[3]); w.z = cvtpk(v1[0], v1[1]); w.w = cvtpk(v1[2], v1[3]); *(u32x4*)p = w; }

struct EpiP1a {
    static constexpr bool PERM = true;
    bf16_t* ZY; bf16_t* XBC; float* DT; const float* dt_bias;
    DI void operator()(AccRef acc, const Unit& u, int wr, int wc, int fr, int fq) const {
        const int row0 = u.pm * 256 + wr * 64 + fr;
        if (u.pn < 20) {
            const bool isz = u.pn < 8;
            bf16_t* base = isz ? ZY : XBC; const int ld = isz ? DIN : XBCW; const int col0 = (isz ? u.pn : u.pn - 8) * 256 + wc * 32 + 8 * fq;
#pragma unroll
            for (int ai = 0; ai < 2; ++ai)
#pragma unroll
                for (int m = 0; m < 4; ++m) { bf16_t* rowp = base + (size_t)(row0 + ai * 128 + m * 16) * ld + col0;
#pragma unroll
                    for (int bj = 0; bj < 2; ++bj) { f32x4 v0 = acc[ai][bj][m][0], v1 = acc[ai][bj][m][1];
                        if (isz) {
#pragma unroll
                            for (int j = 0; j < 4; ++j) { v0[j] = silu_f(v0[j]); v1[j] = silu_f(v1[j]); } }
                        st8(rowp + bj * 128, v0, v1); } }
        } else if (wc == 0) {
            const int c0 = 8 * fq;
            const f32x4 b0 = *(const f32x4*)(dt_bias + c0), b1 = *(const f32x4*)(dt_bias + c0 + 4);
#pragma unroll
            for (int ai = 0; ai < 2; ++ai)
#pragma unroll
                for (int m = 0; m < 4; ++m) { float* rowp = DT + (size_t)(row0 + ai * 128 + m * 16) * NHS + c0;
                    f32x4 v0 = acc[ai][0][m][0] + b0, v1 = acc[ai][0][m][1] + b1;
#pragma unroll
                    for (int j = 0; j < 4; ++j) { v0[j] = v0[j] > 20.f ? v0[j] : log1pf(__expf(v0[j])); v1[j] = v1[j] > 20.f ? v1[j] : log1pf(__expf(v1[j])); }
                    *(f32x4*)rowp = v0; *(f32x4*)(rowp + 4) = v1; }
        }
    }
};
struct EpiP1b {
    static constexpr bool PERM = true;
    bf16_t* QKV; bf16_t* GATES; const float* ROPE;
    DI void operator()(AccRef acc, const Unit& u, int wr, int wc, int fr, int fq) const {
        const int row0 = u.pm * 256 + wr * 64 + fr;
        const bool isg = u.pn >= 12;
        bf16_t* base = isg ? GATES : QKV; const int ld = isg ? DIN : XBCW; const int col0 = (isg ? u.pn - 12 : u.pn) * 256 + wc * 32 + 8 * fq;
        const bool rope = (u.pn < 8) && ((wc & 1) == 0);
        const float sc = (u.pn < 4) ? QSCALE : 1.f;
#pragma unroll
        for (int ai = 0; ai < 2; ++ai)
#pragma unroll
            for (int m = 0; m < 4; ++m) { const int row = row0 + ai * 128 + m * 16; bf16_t* rowp = base + (size_t)row * ld + col0;
                f32x4 c0v, c1v, s0v, s1v;
                if (rope) { const float* rp = ROPE + (size_t)row * 16; c0v = *(const f32x4*)rp; c1v = *(const f32x4*)(rp + 4); s0v = *(const f32x4*)(rp + 8); s1v = *(const f32x4*)(rp + 12);
                    if (fq == 1) { s0v = -s0v; s1v = -s1v; } }
#pragma unroll
                for (int bj = 0; bj < 2; ++bj) { f32x4 v0 = acc[ai][bj][m][0], v1 = acc[ai][bj][m][1];
                    if (isg) {
#pragma unroll
                        for (int j = 0; j < 4; ++j) { v0[j] = sigmoid_f(v0[j]); v1[j] = sigmoid_f(v1[j]); }
                    } else if (rope) {
                        f32x4 p0, p1;
#pragma unroll
                        for (int j = 0; j < 4; ++j) { p0[j] = __shfl_xor(v0[j], 16); p1[j] = __shfl_xor(v1[j], 16); }
                        if (fq < 2) { v0 = v0 * c0v - p0 * s0v; v1 = v1 * c1v - p1 * s1v; }
                    }
                    v0 = v0 * sc; v1 = v1 * sc;
                    st8(rowp + bj * 128, v0, v1); } }
    }
};
struct EpiSsmOut {
    static constexpr bool PERM = true;
    bf16_t* MIXIN; const bf16_t* GATES;
    DI void operator()(AccRef acc, const Unit& u, int wr, int wc, int fr, int fq) const {
        const int row0 = u.pm * 256 + wr * 64 + fr, col0 = u.pn * 256 + wc * 32 + 8 * fq;
#pragma unroll
        for (int ai = 0; ai < 2; ++ai)
#pragma unroll
            for (int m = 0; m < 4; ++m) { const int row = row0 + ai * 128 + m * 16;
#pragma unroll
                for (int bj = 0; bj < 2; ++bj) { const u32x4 gw = *(const u32x4*)(GATES + (size_t)row * DIN + col0 + bj * 128);
                    f32x4 v0 = acc[ai][bj][m][0], v1 = acc[ai][bj][m][1];
                    v0[0] *= bflo(gw.x); v0[1] *= bfhi(gw.x); v0[2] *= bflo(gw.y); v0[3] *= bfhi(gw.y); v1[0] *= bflo(gw.z); v1[1] *= bfhi(gw.z); v1[2] *= bflo(gw.w); v1[3] *= bfhi(gw.w);
                    st8(MIXIN + (size_t)row * DM + col0 + bj * 128, v0, v1); } }
    }
};
struct EpiAttOut {
    static constexpr bool PERM = true;
    bf16_t* MIXIN; const bf16_t* GATES;
    DI void operator()(AccRef acc, const Unit& u, int wr, int wc, int fr, int fq) const {
        const int row0 = u.pm * 256 + wr * 64 + fr, col0 = u.pn * 256 + wc * 32 + 8 * fq;
#pragma unroll
        for (int ai = 0; ai < 2; ++ai)
#pragma unroll
            for (int m = 0; m < 4; ++m) { const int row = row0 + ai * 128 + m * 16;
#pragma unroll
                for (int bj = 0; bj < 2; ++bj) { const u32x4 gw = *(const u32x4*)(GATES + (size_t)row * DIN + DM + col0 + bj * 128);
                    bf16_t* mp = MIXIN + (size_t)row * DM + col0 + bj * 128; const u32x4 pw = *(const u32x4*)mp;
                    f32x4 v0 = acc[ai][bj][m][0], v1 = acc[ai][bj][m][1];
                    v0[0] = v0[0] * bflo(gw.x) + bflo(pw.x); v0[1] = v0[1] * bfhi(gw.x) + bfhi(pw.x); v0[2] = v0[2] * bflo(gw.y) + bflo(pw.y); v0[3] = v0[3] * bfhi(gw.y) + bfhi(pw.y);
                    v1[0] = v1[0] * bflo(gw.z) + bflo(pw.z); v1[1] = v1[1] * bfhi(gw.z) + bfhi(pw.z); v1[2] = v1[2] * bflo(gw.w) + bflo(pw.w); v1[3] = v1[3] * bfhi(gw.w) + bfhi(pw.w);
                    st8(mp, v0, v1); } }
    }
};
struct EpiF32 {
    static constexpr bool PERM = false;
    float* O;
    DI void operator()(AccRef acc, const Unit& u, int wr, int wc, int fr, int fq) const {
        const int row0 = u.pm * 256 + wr * 64 + fr, col0 = u.pn * 256 + wc * 32 + 4 * fq;
#pragma unroll
        for (int ai = 0; ai < 2; ++ai)
#pragma unroll
            for (int m = 0; m < 4; ++m) { float* rowp = O + (size_t)(row0 + ai * 128 + m * 16) * DM + col0;
#pragma unroll
                for (int bj = 0; bj < 2; ++bj)
#pragma unroll
                    for (int n = 0; n < 2; ++n) *(f32x4*)(rowp + bj * 128 + n * 16) = acc[ai][bj][m][n]; }
    }
};
struct EpiSwiglu {
    static constexpr bool PERM = true;
    bf16_t* HID;
    DI void operator()(AccRef acc, const Unit& u, int wr, int wc, int fr, int fq) const {
        const int row0 = u.pm * 256 + wr * 64 + fr, col0 = u.pn * 128 + wc * 32 + 8 * fq;
#pragma unroll
        for (int ai = 0; ai < 2; ++ai)
#pragma unroll
            for (int m = 0; m < 4; ++m) { f32x4 v0, v1;
#pragma unroll
                for (int j = 0; j < 4; ++j) { v0[j] = silu_f(acc[ai][0][m][0][j]) * acc[ai][1][m][0][j]; v1[j] = silu_f(acc[ai][0][m][1][j]) * acc[ai][1][m][1][j]; }
                st8(HID + (size_t)(row0 + ai * 128 + m * 16) * FFH + col0, v0, v1); }
    }
};

DI float wave_sum(float v) {
#pragma unroll
    for (int o = 1; o < 64; o <<= 1) v += __shfl_xor(v, o);
    return v;
}
DI void transpose_item(const float* W, int ldw, int src_n0, int k0, bf16_t* WT, int ldt, int dst_row0, const float* kscale, LAS float* scr, int lane) {
#pragma unroll 8
    for (int i = 0; i < 32; ++i) { const int kk = 2 * i + (lane >> 5); float v = W[(size_t)(k0 + kk) * ldw + src_n0 + (lane & 31)]; if (kscale) v *= kscale[k0 + kk]; scr[kk * 33 + (lane & 31)] = v; }
    asm volatile("s_waitcnt lgkmcnt(0)" ::: "memory");
    const int c = lane & 7;
#pragma unroll
    for (int j = 0; j < 4; ++j) { const int n = (lane >> 3) + 8 * j; const LAS float* s = scr + (8 * c) * 33 + n;
        u32x4 o; o.x = cvtpk(s[0 * 33], s[1 * 33]); o.y = cvtpk(s[2 * 33], s[3 * 33]); o.z = cvtpk(s[4 * 33], s[5 * 33]); o.w = cvtpk(s[6 * 33], s[7 * 33]);
        *(u32x4*)(WT + (size_t)(dst_row0 + n) * ldt + k0 + 8 * c) = o; }
    asm volatile("s_waitcnt lgkmcnt(0)" ::: "memory");
}
DI void rms_row_to_bf16(const float* xrow, const float* w, bf16_t* orow, int lane) {
    const f32x4* xr = (const f32x4*)xrow + lane; const f32x4* wr_ = (const f32x4*)w + lane;
    f32x4 v[4]; float s = 0.f;
#pragma unroll
    for (int j = 0; j < 4; ++j) { v[j] = xr[64 * j]; s += (v[j].x * v[j].x + v[j].y * v[j].y) + (v[j].z * v[j].z + v[j].w * v[j].w); }
    const float rstd = rsqrtf(wave_sum(s) * (1.f / DM) + EPS);
    u32x2* o8 = (u32x2*)orow + lane;
#pragma unroll
    for (int j = 0; j < 4; ++j) { const f32x4 g = wr_[64 * j]; u32x2 o; o.x = cvtpk(v[j].x * rstd * g.x, v[j].y * rstd * g.y); o.y = cvtpk(v[j].z * rstd * g.z, v[j].w * rstd * g.w); o8[64 * j] = o; }
}

DI void p0_prologue(const Params& P, LAS unsigned char* lds, int G) {
    const int tid = otid(), lane = tid & 63, wave = tid >> 6;
    LAS float* scr = (LAS float*)(lds + wave * 16384);
    const int gw = blockIdx.x * 8 + wave, NGW = G * 8;
    unsigned char* ws = P.ws;
    bf16_t* Win = (bf16_t*)(ws + WS_WIN); bf16_t* Wssm = (bf16_t*)(ws + WS_WSSM); bf16_t* Watt = (bf16_t*)(ws + WS_WATT); bf16_t* Wmix = (bf16_t*)(ws + WS_WMIX);
    bf16_t* Wgu = (bf16_t*)(ws + WS_WGU); bf16_t* Wdn = (bf16_t*)(ws + WS_WDN);
    constexpr int INC = 10272;
    constexpr int I_IN = 16 * 320, I_DT = 16, I_SSM = 32 * 32, I_ATT = 16 * 32, I_MIX = 16 * 32, I_G = 16 * 88, I_U = 16 * 88, I_D = 44 * 32;
    constexpr int NIT = I_IN + I_DT + I_SSM + I_ATT + I_MIX + I_G + I_U + I_D;
    for (int it = gw; it < NIT; it += NGW) {
        int r = it;
        if (r < I_IN) { const int kb = r / 320, nb = r % 320; const int n0 = nb * 32;
            const int src = n0 < 5120 ? n0 : n0 + 32; const int dst = n0 < 5120 ? n0 : n0 + 256;
            transpose_item(P.w_in, INC, src, kb * 64, Win, DM, dst, nullptr, scr, lane); continue; } r -= I_IN;
        if (r < I_DT) { transpose_item(P.w_in, INC, 5120, r * 64, Win, DM, 5120, nullptr, scr, lane); continue; } r -= I_DT;
        if (r < I_SSM) { const int kb = r / 32, nb = r % 32; transpose_item(P.w_ssm_out, DM, nb * 32, kb * 64, Wssm, DIN, nb * 32, P.ssm_norm_w, scr, lane); continue; } r -= I_SSM;
        if (r < I_ATT) { const int kb = r / 32, nb = r % 32; transpose_item(P.w_attn_out, DM, nb * 32, kb * 64, Watt, DM, nb * 32, nullptr, scr, lane); continue; } r -= I_ATT;
        if (r < I_MIX) { const int kb = r / 32, nb = r % 32; transpose_item(P.w_mix, DM, nb * 32, kb * 64, Wmix, DM, nb * 32, nullptr, scr, lane); continue; } r -= I_MIX;
        if (r < I_G) { const int kb = r / 88, nb = r % 88; const int n0 = nb * 32; transpose_item(P.w_gate, FFH, n0, kb * 64, Wgu, DM, 256 * (n0 >> 7) + (n0 & 127), nullptr, scr, lane); continue; } r -= I_G;
        if (r < I_U) { const int kb = r / 88, nb = r % 88; const int n0 = nb * 32; transpose_item(P.w_up, FFH, n0, kb * 64, Wgu, DM, 256 * (n0 >> 7) + 128 + (n0 & 127), nullptr, scr, lane); continue; } r -= I_U;
        { const int kb = r / 32, nb = r % 32; transpose_item(P.w_down, DM, nb * 32, kb * 64, Wdn, FFH, nb * 32, nullptr, scr, lane); }
    }
    bf16_t* XN = (bf16_t*)(ws + WS_XN);
    for (int m = gw; m < T_TOK; m += NGW) rms_row_to_bf16(P.x + (size_t)m * DM, P.n_pre_mix, XN + (size_t)m * DM, lane);
    float* ROPE = (float*)(ws + WS_ROPE);
    for (int e = blockIdx.x * 512 + tid; e < T_TOK * 8; e += G * 512) {
        const int t = e >> 3, i = e & 7;
        const float invf = i == 0 ? 1.0f : i == 1 ? 0.1939227432012558f : i == 2 ? 0.03760603070259094f : i == 3 ? 0.007292664609849453f : i == 4 ? 0.0014142135623842478f
                          : i == 5 ? 0.00027424818836152554f : i == 6 ? 5.318296098266728e-05f : 1.0313386155758053e-05f;
        const float ang = (float)P.pos[t] * invf;
        const double a = (double)ang; const double k = rint(a * 0.15915494309189535); const double rr = a - k * 6.283185307179586;
        const float rf = (float)rr;
        ROPE[t * 16 + i] = __cosf(rf); ROPE[t * 16 + 8 + i] = __sinf(rf);
    }
}

DI s16x4 trrd(const LAS unsigned char* p) { return __builtin_bit_cast(s16x4, __builtin_amdgcn_ds_read_tr16_b64_v4i16((LAS s16x4*)p)); }
DI bf16x8 cat8(s16x4 lo, s16x4 hi) { return __builtin_shufflevector(lo, hi, 0, 1, 2, 3, 4, 5, 6, 7); }
#define MFMA32(a, b, c) __builtin_amdgcn_mfma_f32_32x32x16_bf16((a), (b), (c), 0, 0, 0)
DI int crow(int i, int hi) { return (i & 3) + 8 * (i >> 2) + 4 * hi; }

constexpr int SS_BC = 272, SS_X = 192;
constexpr int L_CS = 0, L_BS = L_CS + 128 * SS_BC, L_HS = L_BS + 128 * SS_BC, L_XS = L_HS + 64 * SS_BC, L_XW = L_XS + 128 * SS_X, L_DT = L_XW + 128 * SS_X, L_FS = L_DT + 512, L_ACS = L_FS + 512, L_SSD_END = L_ACS + 512;
static_assert(L_SSD_END <= 147456 - 128, "ssd lds");

template <int R> DI void conv_load(const bf16_t* XBC, int t0, int r0, bool first, int col, u32x4 (&in)[R + 3]) {
#pragma unroll
    for (int i = 0; i < R + 3; ++i) { const int rr = r0 - 3 + i; if (first && rr < 0) in[i] = (u32x4){0u, 0u, 0u, 0u}; else in[i] = *(const u32x4*)(XBC + (size_t)(t0 + rr) * XBCW + col); }
}
template <int R> DI void conv_apply(const u32x4 (&in)[R + 3], int col, const float* conv_w, const float* conv_b, float (&outv)[R][8]) {
    float w[4][8], bsv[8];
#pragma unroll
    for (int j = 0; j < 4; ++j) { const f32x4 a = *(const f32x4*)(conv_w + j * XBCW + col), b = *(const f32x4*)(conv_w + j * XBCW + col + 4);
        w[j][0] = a.x; w[j][1] = a.y; w[j][2] = a.z; w[j][3] = a.w; w[j][4] = b.x; w[j][5] = b.y; w[j][6] = b.z; w[j][7] = b.w; }
    { const f32x4 a = *(const f32x4*)(conv_b + col), b = *(const f32x4*)(conv_b + col + 4); bsv[0] = a.x; bsv[1] = a.y; bsv[2] = a.z; bsv[3] = a.w; bsv[4] = b.x; bsv[5] = b.y; bsv[6] = b.z; bsv[7] = b.w; }
#pragma unroll
    for (int r = 0; r < R; ++r) {
#pragma unroll
        for (int c = 0; c < 8; ++c) outv[r][c] = bsv[c];
#pragma unroll
        for (int j = 0; j < 4; ++j) { const u32x4 v = in[r + j];
            outv[r][0] += w[j][0] * bflo(v.x); outv[r][1] += w[j][1] * bfhi(v.x); outv[r][2] += w[j][2] * bflo(v.y); outv[r][3] += w[j][3] * bfhi(v.y);
            outv[r][4] += w[j][4] * bflo(v.z); outv[r][5] += w[j][5] * bfhi(v.z); outv[r][6] += w[j][6] * bflo(v.w); outv[r][7] += w[j][7] * bfhi(v.w); }
#pragma unroll
        for (int c = 0; c < 8; ++c) outv[r][c] = silu_f(outv[r][c]);
    }
}

DI void p1c_prepass(const Params& P, int G) {
    const int tid = otid(), lane = tid & 63, wave = tid >> 6, r32 = lane & 31, hi = lane >> 5;
    const bf16_t* XBC = (const bf16_t*)(P.ws + WS_R96); bf16_t* BCc = (bf16_t*)P.out;
    for (int it = blockIdx.x * 512 + tid; it < (T_TOK / 8) * 128; it += G * 512) {
        const int cg8 = it & 127, seg = it >> 7; const int t0 = seg * 8; const bool first = (t0 & (SEQ - 1)) == 0;
        const int col = DIN + cg8 * 8;
        u32x4 in[11]; conv_load<8>(XBC, t0, 0, first, col, in);
        float ov[8][8]; conv_apply<8>(in, col, P.conv_w, P.conv_b, ov);
#pragma unroll
        for (int r = 0; r < 8; ++r) { u32x4 w; w.x = cvtpk(ov[r][0], ov[r][1]); w.y = cvtpk(ov[r][2], ov[r][3]); w.z = cvtpk(ov[r][4], ov[r][5]); w.w = cvtpk(ov[r][6], ov[r][7]);
            *(u32x4*)(BCc + (size_t)(t0 + r) * 1024 + cg8 * 8) = w; }
    }
    const int gw = blockIdx.x * 8 + wave;
    if ((gw & 3) == 0 && (gw >> 2) < T_TOK / 32) {
        const int rb = gw >> 2;
        const bf16_t* ap = (const bf16_t*)(P.ws + WS_XN) + (size_t)(32 * rb + r32) * DM + 8 * hi;
        const bf16_t* bp = (const bf16_t*)(P.ws + WS_WIN) + (size_t)(5120 + r32) * DM + 8 * hi;
        f32x16 acc;
#pragma unroll
        for (int i = 0; i < 16; ++i) acc[i] = 0.f;
#pragma unroll 8
        for (int ks = 0; ks < 64; ++ks) { const bf16x8 a = *(const bf16x8*)(ap + 16 * ks), bb = *(const bf16x8*)(bp + 16 * ks); acc = MFMA32(a, bb, acc); }
        float* DT = (float*)(P.ws + WS_DT); const float bias = P.dt_bias[r32];
#pragma unroll
        for (int i = 0; i < 16; ++i) { float v = acc[i] + bias; v = v > 20.f ? v : log1pf(__expf(v)); DT[(size_t)(32 * rb + crow(i, hi)) * NHS + r32] = v; }
    }
}

DI void ssd_unit(const Params& P, LAS unsigned char* lds, int b, int h, bool dostore = true) {
    const int tid = otid(), lane = tid & 63, wid = __builtin_amdgcn_readfirstlane(tid >> 6), r32 = lane & 31, hi = lane >> 5;
    const int q4 = (lane & 15) >> 2, p4 = lane & 3, g1 = (lane >> 4) & 1;
    const int g = h >> 3;
    bf16_t* ZY = (bf16_t*)(P.ws + WS_ZY); const bf16_t* XBC = (const bf16_t*)(P.ws + WS_R96); const float* DT = (const float*)(P.ws + WS_DT); const bf16_t* BCc = (const bf16_t*)P.out;
    const float Ah = -__expf(P.a_log[h]), Dh = P.d_skip[h];
    LAS float* sm_dt = (LAS float*)(lds + L_DT); LAS float* sm_acs = (LAS float*)(lds + L_ACS); LAS float* sm_fs = (LAS float*)(lds + L_FS);
    const int pb = wid & 1, lb = wid >> 1;
    f32x16 hacc;
#pragma unroll
    for (int i = 0; i < 16; ++i) hacc[i] = 0.f;
    const int bcch = tid & 31, bcrow = tid >> 5;
    const bf16_t* bcsrc = BCc + (size_t)(b * SEQ + bcrow) * 1024 + (bcch < 16 ? g * 128 + bcch * 8 : 512 + g * 128 + (bcch - 16) * 8);
    LAS unsigned char* bcdst = lds + (bcch < 16 ? L_BS : L_CS) + bcrow * SS_BC + (bcch & 15) * 16;
    const int cgx = tid & 7, xr0 = (tid >> 3) * 2, xcol = h * 64 + cgx * 8;
    u32x4 bcr[8], xin[5]; float dt0 = 0.f, dt1 = 0.f;
#define SSD_PREFETCH(cc) do { const int t0n = b * SEQ + (cc) * 128; \
        _Pragma("unroll") for (int j = 0; j < 8; ++j) bcr[j] = *(const u32x4*)(bcsrc + (size_t)((cc) * 128 + 16 * j) * 1024); \
        conv_load<2>(XBC, t0n, xr0, (cc) == 0, xcol, xin); \
        if (wid == 0) { dt0 = DT[(size_t)(t0n + 2 * lane) * NHS + h]; dt1 = DT[(size_t)(t0n + 2 * lane + 1) * NHS + h]; } } while (0)
    SSD_PREFETCH(0);
    for (int c = 0; c < 16; ++c) {
        const int t0 = b * SEQ + c * 128;
        if (wid == 0) {
            const float e0 = dt0 * Ah, e1 = dt1 * Ah; float sc = e0 + e1;
#pragma unroll
            for (int d = 1; d < 64; d <<= 1) { const float t = __shfl_up(sc, d); if (lane >= d) sc += t; }
            sm_dt[2 * lane] = dt0; sm_dt[2 * lane + 1] = dt1; sm_acs[2 * lane] = sc - e1; sm_acs[2 * lane + 1] = sc;
            const float bend = __shfl(sc, lane | 15);
            sm_fs[2 * lane] = __expf(bend - (sc - e1)) * dt0; sm_fs[2 * lane + 1] = __expf(bend - sc) * dt1;
        }
#pragma unroll
        for (int j = 0; j < 8; ++j) *(LAS u32x4*)(bcdst + 16 * j * SS_BC) = bcr[j];
#pragma unroll
        for (int i = 0; i < 16; ++i) { const int p = 32 * pb + crow(i, hi), n = 32 * lb + r32; *(LAS bf16_t*)(lds + L_HS + p * SS_BC + n * 2) = (bf16_t)(cvtpk(hacc[i], 0.f) & 0xffffu); }
        __syncthreads();
        const float a_end = sm_acs[127];
        { float ov[2][8]; conv_apply<2>(xin, xcol, P.conv_w, P.conv_b, ov);
#pragma unroll
            for (int r = 0; r < 2; ++r) { const int l = xr0 + r; const float wl = sm_dt[l] * __expf(a_end - sm_acs[l]);
                u32x4 w; w.x = cvtpk(ov[r][0], ov[r][1]); w.y = cvtpk(ov[r][2], ov[r][3]); w.z = cvtpk(ov[r][4], ov[r][5]); w.w = cvtpk(ov[r][6], ov[r][7]);
                *(LAS u32x4*)(lds + L_XS + l * SS_X + cgx * 16) = w;
                w.x = cvtpk(ov[r][0] * wl, ov[r][1] * wl); w.y = cvtpk(ov[r][2] * wl, ov[r][3] * wl); w.z = cvtpk(ov[r][4] * wl, ov[r][5] * wl); w.w = cvtpk(ov[r][6] * wl, ov[r][7] * wl);
                *(LAS u32x4*)(lds + L_XW + l * SS_X + cgx * 16) = w; } }
        if (c + 1 < 16) SSD_PREFETCH(c + 1);
        __syncthreads();
        bf16x8 cf[8];
#pragma unroll
        for (int ks = 0; ks < 8; ++ks) cf[ks] = *(const LAS bf16x8*)(lds + L_CS + (32 * lb + r32) * SS_BC + (16 * ks + 8 * hi) * 2);
        f32x16 acc;
#pragma unroll
        for (int i = 0; i < 16; ++i) acc[i] = 0.f;
#pragma unroll
        for (int ks = 0; ks < 8; ++ks) { const bf16x8 a = *(const LAS bf16x8*)(lds + L_HS + (32 * pb + r32) * SS_BC + (16 * ks + 8 * hi) * 2); acc = MFMA32(a, cf[ks], acc); }
        const float acs_l = sm_acs[32 * lb + r32];
        { const float ea = __expf(acs_l);
#pragma unroll
          for (int i = 0; i < 16; ++i) acc[i] *= ea; }
        for (int sb = 0; sb <= lb; ++sb) {
            f32x16 st;
#pragma unroll
            for (int i = 0; i < 16; ++i) st[i] = 0.f;
#pragma unroll
            for (int ks = 0; ks < 8; ++ks) { const bf16x8 a = *(const LAS bf16x8*)(lds + L_BS + (32 * sb + r32) * SS_BC + (16 * ks + 8 * hi) * 2); st = MFMA32(a, cf[ks], st); }
            const int l = 32 * lb + r32;
            if (sb < lb) {
                const float fl = __expf(acs_l - sm_acs[32 * sb + 31]);
#pragma unroll
                for (int i = 0; i < 16; ++i) st[i] *= fl * sm_fs[32 * sb + crow(i, hi)];
            } else {
#pragma unroll
                for (int i = 0; i < 16; ++i) { const int s = 32 * sb + crow(i, hi); float v = st[i] * __expf(acs_l - sm_acs[s]) * sm_dt[s]; v = (s <= l) ? v : 0.f; if (s == l) v += Dh; st[i] = v; }
            }
#pragma unroll
            for (int k2 = 0; k2 < 2; ++k2) {
                u32x4 mw; mw.x = cvtpk(st[8 * k2 + 0], st[8 * k2 + 1]); mw.y = cvtpk(st[8 * k2 + 2], st[8 * k2 + 3]); mw.z = cvtpk(st[8 * k2 + 4], st[8 * k2 + 5]); mw.w = cvtpk(st[8 * k2 + 6], st[8 * k2 + 7]);
                const LAS unsigned char* xp = lds + L_XS + (32 * sb + 16 * k2 + 4 * hi + q4) * SS_X + (32 * pb + 16 * g1) * 2 + 8 * p4;
                const bf16x8 a = cat8(trrd(xp), trrd(xp + 8 * SS_X));
                acc = MFMA32(a, __builtin_bit_cast(bf16x8, mw), acc);
            }
        }
        {
            const size_t trow = (size_t)(t0 + 32 * lb + r32) * DIN + h * 64 + 32 * pb + 4 * hi;
#pragma unroll
            for (int g4 = 0; g4 < 4; ++g4) { bf16_t* zp = ZY + trow + 8 * g4; const u32x2 zw = *(const u32x2*)zp;
                u32x2 o; o.x = cvtpk(acc[4 * g4 + 0] * bflo(zw.x), acc[4 * g4 + 1] * bfhi(zw.x)); o.y = cvtpk(acc[4 * g4 + 2] * bflo(zw.y), acc[4 * g4 + 3] * bfhi(zw.y));
                if (dostore) *(u32x2*)zp = o; }
        }
        { const float ee = __expf(a_end);
#pragma unroll
          for (int i = 0; i < 16; ++i) hacc[i] *= ee; }
#pragma unroll
        for (int ks = 0; ks < 8; ++ks) {
            const LAS unsigned char* xp = lds + L_XW + (16 * ks + 8 * hi + q4) * SS_X + (32 * pb + 16 * g1) * 2 + 8 * p4;
            const LAS unsigned char* bp = lds + L_BS + (16 * ks + 8 * hi + q4) * SS_BC + (32 * lb + 16 * g1) * 2 + 8 * p4;
            const bf16x8 a = cat8(trrd(xp), trrd(xp + 4 * SS_X));
            const bf16x8 bb = cat8(trrd(bp), trrd(bp + 4 * SS_BC));
            hacc = MFMA32(a, bb, hacc);
        }
        __syncthreads();
    }
#undef SSD_PREFETCH
}

constexpr int AT_KS = 144, AT_VS = 320;
constexpr int LA_K = 0, LA_V = LA_K + 2 * 64 * AT_KS, LA_ST = LA_V + 2 * 64 * AT_VS, LA_END = LA_ST + 8 * 32 * 64 * 4;
static_assert(LA_END <= 147456 - 128, "attn lds");

DI void attn_unit(const Params& P, LAS unsigned char* lds, int b, int hh, int qb, float lam, bool dostore = true) {
    const int tid = otid(), lane = tid & 63, wid = __builtin_amdgcn_readfirstlane(tid >> 6), r32 = lane & 31, hi = lane >> 5;
    const int q4 = (lane & 15) >> 2, p4 = lane & 3, g1 = (lane >> 4) & 1;
    bf16_t* QKV = (bf16_t*)(P.ws + WS_R96);
    const size_t rowbase = (size_t)b * SEQ; const int q0 = qb * 256;
    const int qmin_w = q0 + wid * 32;
    const int ntile = (q0 + 256) / 64;
    LAS unsigned* stash = (LAS unsigned*)(lds + LA_ST) + wid * 2048 + lane;
    const int krow_ = tid >> 3, kch = tid & 7, vrow = tid >> 4, vch = tid & 15;
    for (int sub = 0; sub < 2; ++sub) {
        const bf16_t* Kg = QKV + rowbase * XBCW + DM + hh * 128 + sub * 64 + kch * 8;
        const bf16_t* Vg = QKV + rowbase * XBCW + 2 * DM + hh * 128 + vch * 8;
        bf16x8 qf[4];
        { const bf16_t* Qg = QKV + (rowbase + qmin_w + r32) * XBCW + hh * 128 + sub * 64 + hi * 8;
#pragma unroll
          for (int d0 = 0; d0 < 4; ++d0) qf[d0] = *(const bf16x8*)(Qg + d0 * 16); }
        float mref = 0.f, lrun = 0.f;
        f32x16 negm;
#pragma unroll
        for (int i = 0; i < 16; ++i) negm[i] = 0.f;
        f32x16 o[4];
#pragma unroll
        for (int e = 0; e < 4; ++e)
#pragma unroll
            for (int i = 0; i < 16; ++i) o[e][i] = 0.f;
        u32x4 kreg, vreg0, vreg1;
        kreg = *(const u32x4*)(Kg + (size_t)krow_ * XBCW); vreg0 = *(const u32x4*)(Vg + (size_t)vrow * XBCW); vreg1 = *(const u32x4*)(Vg + (size_t)(vrow + 32) * XBCW);
        for (int j = 0; j < ntile; ++j) {
            LAS unsigned char* Ks = lds + LA_K + (j & 1) * 64 * AT_KS; LAS unsigned char* Vs = lds + LA_V + (j & 1) * 64 * AT_VS;
            *(LAS u32x4*)(Ks + krow_ * AT_KS + kch * 16) = kreg;
            *(LAS u32x4*)(Vs + vrow * AT_VS + vch * 16) = vreg0; *(LAS u32x4*)(Vs + (vrow + 32) * AT_VS + vch * 16) = vreg1;
            __syncthreads();
            if (j + 1 < ntile) { const size_t ro = (size_t)(j + 1) * 64;
                kreg = *(const u32x4*)(Kg + (ro + krow_) * XBCW); vreg0 = *(const u32x4*)(Vg + (ro + vrow) * XBCW); vreg1 = *(const u32x4*)(Vg + (ro + vrow + 32) * XBCW); }
            if (64 * j <= qmin_w + 31) {
                f32x16 s0, s1;
#pragma unroll
                for (int d0 = 0; d0 < 4; ++d0) {
                    const bf16x8 a0 = *(const LAS bf16x8*)(Ks + r32 * AT_KS + (d0 * 16 + hi * 8) * 2);
                    const bf16x8 a1 = *(const LAS bf16x8*)(Ks + (32 + r32) * AT_KS + (d0 * 16 + hi * 8) * 2);
                    if (d0 == 0) { s0 = MFMA32(a0, qf[0], negm); s1 = MFMA32(a1, qf[0], negm); }
                    else { s0 = MFMA32(a0, qf[d0], s0); s1 = MFMA32(a1, qf[d0], s1); }
                }
                if (64 * j + 63 > qmin_w) {
                    const int qg = qmin_w + r32;
#pragma unroll
                    for (int i = 0; i < 16; ++i) { const int kv = 64 * j + crow(i, hi); if (kv > qg) s0[i] = -INFINITY; if (kv + 32 > qg) s1[i] = -INFINITY; }
                }
                float mx = fmaxf(s0[0], s1[0]);
#pragma unroll
                for (int i = 1; i < 16; ++i) mx = fmaxf(mx, fmaxf(s0[i], s1[i]));
                mx = fmaxf(mx, __shfl_xor(mx, 32));
                if (j == 0 || __builtin_amdgcn_ballot_w64(mx > 8.f) != 0ull) {
                    const float delta = (j == 0) ? mx : fmaxf(mx, 0.f);
                    mref += delta; const float alpha = __builtin_amdgcn_exp2f(-delta); lrun *= alpha;
#pragma unroll
                    for (int i = 0; i < 16; ++i) { s0[i] -= delta; s1[i] -= delta; negm[i] = -mref; }
#pragma unroll
                    for (int e = 0; e < 4; ++e)
#pragma unroll
                        for (int i = 0; i < 16; ++i) o[e][i] *= alpha;
                }
                float rs = 0.f;
#pragma unroll
                for (int i = 0; i < 16; ++i) { s0[i] = __builtin_amdgcn_exp2f(s0[i]); s1[i] = __builtin_amdgcn_exp2f(s1[i]); rs += s0[i] + s1[i]; }
                lrun += rs;
                bf16x8 pf[2][2];
#pragma unroll
                for (int k2 = 0; k2 < 2; ++k2) {
                    u32x4 w; w.x = cvtpk(s0[8 * k2 + 0], s0[8 * k2 + 1]); w.y = cvtpk(s0[8 * k2 + 2], s0[8 * k2 + 3]); w.z = cvtpk(s0[8 * k2 + 4], s0[8 * k2 + 5]); w.w = cvtpk(s0[8 * k2 + 6], s0[8 * k2 + 7]);
                    pf[0][k2] = __builtin_bit_cast(bf16x8, w);
                    w.x = cvtpk(s1[8 * k2 + 0], s1[8 * k2 + 1]); w.y = cvtpk(s1[8 * k2 + 2], s1[8 * k2 + 3]); w.z = cvtpk(s1[8 * k2 + 4], s1[8 * k2 + 5]); w.w = cvtpk(s1[8 * k2 + 6], s1[8 * k2 + 7]);
                    pf[1][k2] = __builtin_bit_cast(bf16x8, w);
                }
#pragma unroll
                for (int e = 0; e < 4; ++e)
#pragma unroll
                    for (int blk = 0; blk < 2; ++blk)
#pragma unroll
                        for (int k2 = 0; k2 < 2; ++k2) {
                            const LAS unsigned char* vp = Vs + (32 * blk + 16 * k2 + 4 * hi + q4) * AT_VS + (32 * e + 16 * g1) * 2 + 8 * p4;
                            const bf16x8 a = cat8(trrd(vp), trrd(vp + 8 * AT_VS));
                            o[e] = MFMA32(a, pf[blk][k2], o[e]);
                        }
            }
        }
        const float ltot = lrun + __shfl_xor(lrun, 32); const float inv = 1.f / ltot;
        if (sub == 0) {
#pragma unroll
            for (int e = 0; e < 4; ++e)
#pragma unroll
                for (int k = 0; k < 8; ++k) stash[(e * 8 + k) * 64] = cvtpk(o[e][2 * k] * inv, o[e][2 * k + 1] * inv);
        } else {
            float ss = 0.f;
#pragma unroll
            for (int e = 0; e < 4; ++e)
#pragma unroll
                for (int k = 0; k < 8; ++k) { const unsigned w = stash[(e * 8 + k) * 64];
                    const float v0 = bflo(w) - lam * (o[e][2 * k] * inv), v1 = bfhi(w) - lam * (o[e][2 * k + 1] * inv);
                    o[e][2 * k] = v0; o[e][2 * k + 1] = v1; ss += v0 * v0 + v1 * v1; }
            ss += __shfl_xor(ss, 32);
            const float rstd = rsqrtf(ss * (1.f / 128.f) + EPS) * (1.f - LAM_INIT);
            bf16_t* Og = QKV + (rowbase + qmin_w + r32) * XBCW + hh * 128 + 4 * hi;
#pragma unroll
            for (int e = 0; e < 4; ++e)
#pragma unroll
                for (int g4 = 0; g4 < 4; ++g4) { const int ec = 32 * e + 8 * g4 + 4 * hi; const f32x4 sw = *(const f32x4*)(P.subln_w + ec);
                    u32x2 w; w.x = cvtpk(o[e][4 * g4 + 0] * rstd * sw.x, o[e][4 * g4 + 1] * rstd * sw.y); w.y = cvtpk(o[e][4 * g4 + 2] * rstd * sw.z, o[e][4 * g4 + 3] * rstd * sw.w);
                    if (dostore) *(u32x2*)(Og + 32 * e + 8 * g4) = w; }
        }
        __syncthreads();
    }
}

DI void ynorm_row(bf16_t* yrow, int lane) {
    u32x4* p = (u32x4*)yrow + lane * 4; u32x4 v[4]; float ss = 0.f;
#pragma unroll
    for (int j = 0; j < 4; ++j) { v[j] = p[j];
        const float a0 = bflo(v[j].x), a1 = bfhi(v[j].x), a2 = bflo(v[j].y), a3 = bfhi(v[j].y), a4 = bflo(v[j].z), a5 = bfhi(v[j].z), a6 = bflo(v[j].w), a7 = bfhi(v[j].w);
        ss += (a0 * a0 + a1 * a1) + (a2 * a2 + a3 * a3) + (a4 * a4 + a5 * a5) + (a6 * a6 + a7 * a7); }
    ss += __shfl_xor(ss, 1); ss += __shfl_xor(ss, 2); ss += __shfl_xor(ss, 4); ss += __shfl_xor(ss, 8);
    const float r = rsqrtf(ss * (1.f / 512.f) + EPS);
#pragma unroll
    for (int j = 0; j < 4; ++j) { u32x4 o;
        o.x = cvtpk(bflo(v[j].x) * r, bfhi(v[j].x) * r); o.y = cvtpk(bflo(v[j].y) * r, bfhi(v[j].y) * r); o.z = cvtpk(bflo(v[j].z) * r, bfhi(v[j].z) * r); o.w = cvtpk(bflo(v[j].w) * r, bfhi(v[j].w) * r);
        p[j] = o; }
}

DI void row_pass5(const float* mixed, const float* x, const float* w1, const float* w2, float* out, bf16_t* h2, int lane) {
    const f32x4* mr = (const f32x4*)mixed + lane; const f32x4* xr = (const f32x4*)x + lane;
    f32x4 v[4]; float s = 0.f;
#pragma unroll
    for (int j = 0; j < 4; ++j) { v[j] = mr[64 * j]; s += (v[j].x * v[j].x + v[j].y * v[j].y) + (v[j].z * v[j].z + v[j].w * v[j].w); }
    const float rstd = rsqrtf(wave_sum(s) * (1.f / DM) + EPS);
    float s2 = 0.f;
#pragma unroll
    for (int j = 0; j < 4; ++j) { const f32x4 g = ((const f32x4*)w1 + lane)[64 * j]; v[j] = xr[64 * j] + v[j] * rstd * g; ((f32x4*)out + lane)[64 * j] = v[j];
        s2 += (v[j].x * v[j].x + v[j].y * v[j].y) + (v[j].z * v[j].z + v[j].w * v[j].w); }
    const float rstd2 = rsqrtf(wave_sum(s2) * (1.f / DM) + EPS);
    u32x2* o8 = (u32x2*)h2 + lane;
#pragma unroll
    for (int j = 0; j < 4; ++j) { const f32x4 g = ((const f32x4*)w2 + lane)[64 * j]; u32x2 o; o.x = cvtpk(v[j].x * rstd2 * g.x, v[j].y * rstd2 * g.y); o.y = cvtpk(v[j].z * rstd2 * g.z, v[j].w * rstd2 * g.w); o8[64 * j] = o; }
}
DI void row_pass8(const float* f, const float* w, float* out, int lane) {
    const f32x4* fr_ = (const f32x4*)f + lane;
    f32x4 v[4]; float s = 0.f;
#pragma unroll
    for (int j = 0; j < 4; ++j) { v[j] = fr_[64 * j]; s += (v[j].x * v[j].x + v[j].y * v[j].y) + (v[j].z * v[j].z + v[j].w * v[j].w); }
    const float rstd = rsqrtf(wave_sum(s) * (1.f / DM) + EPS);
#pragma unroll
    for (int j = 0; j < 4; ++j) { const f32x4 g = ((const f32x4*)w + lane)[64 * j]; f32x4* op = (f32x4*)out + lane + 64 * j; *op = *op + v[j] * rstd * g; }
}


#define XB_TMO      128
#define XB_XCNT(j)  (256  + 64 * (j))
#define XB_XSUB(j)  (1280 + 64 * (j))
#define XB_XGEN(j)  (2304 + 64 * (j))
#define XB_TOP      3328
#define XB_TOPGEN   3392
#define XCD_BAR_WORDS 3456
#define XB_SPIN_CAP (1u << 22)
DI unsigned xb_ld(unsigned* p)              { return __hip_atomic_load(p, __ATOMIC_RELAXED, __HIP_MEMORY_SCOPE_AGENT); }
DI unsigned xb_add(unsigned* p, unsigned v) { return __hip_atomic_fetch_add(p, v, __ATOMIC_RELAXED, __HIP_MEMORY_SCOPE_AGENT); }
DI unsigned xb_xcc_id() { return (unsigned)__builtin_amdgcn_s_getreg((3 << 11) | 20) & 0xFu; }
#define XB_SPIN(cond, bar) do { unsigned _sp = 0; while (cond) { __builtin_amdgcn_s_sleep(1); \
    if ((++_sp & 255u) == 0u) { if (xb_ld(&(bar)[XB_TMO])) break; if (_sp > XB_SPIN_CAP) { atomicAdd(&(bar)[XB_TMO], 1u); break; } } } } while (0)
struct XcdBarrier { unsigned* bar; unsigned x; volatile LAS unsigned* st; };
DI XcdBarrier xcd_barrier_post(unsigned* bar, volatile LAS unsigned* st) {
    XcdBarrier b; b.bar = bar; b.x = xb_xcc_id(); b.st = st;
    if (threadIdx.x == 0) (void)xb_add(&bar[XB_XCNT(b.x)], 1u);
    return b;
}
DI void xcd_barrier_complete(unsigned* bar, unsigned x, unsigned& nloc, unsigned& nx) {
    const unsigned G = gridDim.x * gridDim.y * gridDim.z;
    unsigned sum, cnt, mine, sp = 0u;
    for (;;) {
        sum = 0u; cnt = 0u; mine = 0u;
#pragma unroll
        for (unsigned j = 0; j < 16; ++j) { const unsigned c = xb_ld(&bar[XB_XCNT(j)]); sum += c; cnt += (c > 0u) ? 1u : 0u; mine = (j == x) ? c : mine; }
        if (sum == G) break;
        __builtin_amdgcn_s_sleep(1);
        if ((++sp & 255u) == 0u) { if (xb_ld(&bar[XB_TMO])) break; if (sp > XB_SPIN_CAP) { atomicAdd(&bar[XB_TMO], 1u); break; } }
    }
    nloc = mine > 0u ? mine : 1u; nx = cnt > 0u ? cnt : 1u;
}
DI void xcd_barrier(const XcdBarrier& b) {
    asm volatile("s_waitcnt vmcnt(0)" ::: "memory");
    __syncthreads();
    if (threadIdx.x == 0) {
        unsigned* bar = b.bar;
        __builtin_amdgcn_s_waitcnt(0);
        unsigned nloc = b.st[0], nx = b.st[1];
        if (nloc == 0u) { xcd_barrier_complete(bar, b.x, nloc, nx); b.st[0] = nloc; b.st[1] = nx; }
        const unsigned old = xb_add(&bar[XB_XSUB(b.x)], 1u);
        const unsigned gen = old / nloc;
        if (old + 1u == (gen + 1u) * nloc) {
            __builtin_amdgcn_fence(__ATOMIC_RELEASE, "agent");
            asm volatile("s_waitcnt vmcnt(0)" ::: "memory");
            const unsigned og = xb_add(&bar[XB_TOP], 1u);
            const unsigned tg = og / nx;
            if (og + 1u == (tg + 1u) * nx) xb_add(&bar[XB_TOPGEN], 1u);
            else XB_SPIN(xb_ld(&bar[XB_TOPGEN]) == tg, bar);
            __builtin_amdgcn_fence(__ATOMIC_ACQUIRE, "agent");
            xb_add(&bar[XB_XGEN(b.x)], 1u);
            asm volatile("s_waitcnt vmcnt(0)" ::: "memory");
        } else {
            XB_SPIN(xb_ld(&bar[XB_XGEN(b.x)]) == gen, bar);
            __builtin_amdgcn_fence(__ATOMIC_ACQUIRE, "agent");
            asm volatile("s_waitcnt vmcnt(0)" ::: "memory");
        }
    }
    __syncthreads();
}

__global__ void __launch_bounds__(512, 2) hybrid_fwd(Params P) {
    extern __shared__ __attribute__((aligned(16))) unsigned char lds_raw[];
    LAS unsigned char* lds = (LAS unsigned char*)lds_raw;
    cg::grid_group grid = cg::this_grid();
    const int G = gridDim.x, NGW = G * 8;
#define PHASE_IDS const int tid = otid(), lane = tid & 63, wave = tid >> 6, gw = blockIdx.x * 8 + wave; (void)tid; (void)lane; (void)wave; (void)gw
    unsigned char* ws = P.ws;
    bf16_t* ZY = (bf16_t*)(ws + WS_ZY); bf16_t* R96 = (bf16_t*)(ws + WS_R96); bf16_t* XN = (bf16_t*)(ws + WS_XN);
    const bf16_t* Win = (const bf16_t*)(ws + WS_WIN); const bf16_t* Wssm = (const bf16_t*)(ws + WS_WSSM); const bf16_t* Watt = (const bf16_t*)(ws + WS_WATT);
    const bf16_t* Wmix = (const bf16_t*)(ws + WS_WMIX); const bf16_t* Wgu = (const bf16_t*)(ws + WS_WGU); const bf16_t* Wdn = (const bf16_t*)(ws + WS_WDN);
    float* DT = (float*)(ws + WS_DT); const float* ROPE = (const float*)(ws + WS_ROPE);
    bf16_t* GATES = (bf16_t*)P.out;
    float* F32 = (float*)(ws + WS_ZY);

    p0_prologue(P, lds, G);
#ifdef PROBE_P0
    __syncthreads(); p0_prologue(P, lds, G);
#endif
    { unsigned* bw = (unsigned*)(ws + WS_BAR); if (blockIdx.x == 0) for (int i = otid(); i < XCD_BAR_WORDS; i += 512) bw[i] = 0u;
      if (otid() < 2) ((volatile LAS unsigned*)(lds + LDS_BYTES - 64))[otid()] = 0u; }
    grid.sync();
    const XcdBarrier xbar = xcd_barrier_post((unsigned*)(ws + WS_BAR), (volatile LAS unsigned*)(lds + LDS_BYTES - 64));
#define GRID_BAR() xcd_barrier(xbar)
#ifdef PROBE_SYNC
    for (int i = 0; i < 10; ++i) GRID_BAR();
#endif
#ifndef REP_P1A
#define REP_P1A 1
#endif
    for (int rep_ = 0; rep_ < REP_P1A; ++rep_) {
    { pg8::Gemm g{XN, Win, T_TOK, N1A, DM, DM}; pg8::StaticOrder S; S.init(T_TOK, N1A, G, (int)blockIdx.x);
      EpiP1a E{ZY, R96, DT, P.dt_bias};
      pg8::gemm_phase<EpiP1a, pg8::StaticOrder, true, true>(lds, g, S, E); }
    }
    GRID_BAR();
#ifndef REP_P1C
#define REP_P1C 1
#endif
    for (int rep_ = 0; rep_ < REP_P1C; ++rep_) {
    p1c_prepass(P, G);
    }
    GRID_BAR();
#ifdef PROBE_SSD
    { const int one = oone(); for (int rep = 0; rep < 2; ++rep) for (int u = blockIdx.x; u < NB * NHS; u += G) ssd_unit(P, lds, u >> 5, u & 31, rep == one); }
#else
    for (int u = blockIdx.x; u < NB * NHS; u += G) ssd_unit(P, lds, u >> 5, u & 31);
#endif
    GRID_BAR();
    { pg8::Gemm g{XN, Win + (size_t)N1B_ROW0 * DM, T_TOK, N1B, DM, DM}; pg8::StaticOrder S; S.init(T_TOK, N1B, G, (int)blockIdx.x);
      EpiP1b E{R96, GATES, ROPE};
      pg8::gemm_phase<EpiP1b, pg8::StaticOrder, true, true>(lds, g, S, E); }
    GRID_BAR();
    {
        PHASE_IDS;
        LAS float* lamp = (LAS float*)(lds + LDS_BYTES - 128);
        if (wave == 0) { const float a = wave_sum(P.lq1[lane] * P.lk1[lane]), c = wave_sum(P.lq2[lane] * P.lk2[lane]); if (lane == 0) lamp[0] = expf(a) - expf(c) + LAM_INIT; }
        __syncthreads();
        const float lam = lamp[0];
#ifdef PROBE_ATT
        { const int one = oone(); for (int rep = 0; rep < 2; ++rep) for (int it = blockIdx.x; it < 256; it += G) {
            const int bh = it >> 2, s = it & 3;
            attn_unit(P, lds, bh >> 3, bh & 7, 7 - s, lam, rep == one);
            attn_unit(P, lds, bh >> 3, bh & 7, s, lam, rep == one);
        } }
#else
        for (int it = blockIdx.x; it < 256; it += G) {
            const int bh = it >> 2, s = it & 3;
            attn_unit(P, lds, bh >> 3, bh & 7, 7 - s, lam);
            attn_unit(P, lds, bh >> 3, bh & 7, s, lam);
        }
#endif
        for (int m = gw; m < T_TOK; m += NGW) ynorm_row(ZY + (size_t)m * DIN, lane);
    }
    GRID_BAR();
#ifndef REP_P3
#define REP_P3 1
#endif
    for (int rep_ = 0; rep_ < REP_P3; ++rep_) {
    { bf16_t* MIXIN = XN;
      { pg8::Gemm g{ZY, Wssm, T_TOK, DM, DIN, DIN}; pg8::StaticOrder S; S.init(T_TOK, DM, G, (int)blockIdx.x); EpiSsmOut E{MIXIN, GATES};
        pg8::gemm_phase<EpiSsmOut, pg8::StaticOrder, true, true>(lds, g, S, E); }
      { pg8::Gemm g{R96, Watt, T_TOK, DM, DM, XBCW}; pg8::StaticOrder S; S.init(T_TOK, DM, G, (int)blockIdx.x); EpiAttOut E{MIXIN, GATES};
        pg8::gemm_phase<EpiAttOut, pg8::StaticOrder, true, true>(lds, g, S, E); } }
    }
    GRID_BAR();
#ifndef REP_P4
#define REP_P4 1
#endif
    for (int rep_ = 0; rep_ < REP_P4; ++rep_) {
    { pg8::Gemm g{XN, Wmix, T_TOK, DM, DM, DM}; pg8::StaticOrder S; S.init(T_TOK, DM, G, (int)blockIdx.x); EpiF32 E{F32};
      pg8::gemm_phase<EpiF32, pg8::StaticOrder, true, true>(lds, g, S, E); }
    }
    GRID_BAR();
#ifndef REP_P5
#define REP_P5 1
#endif
    for (int rep_ = 0; rep_ < REP_P5; ++rep_) {
    { PHASE_IDS;
    for (int m = gw; m < T_TOK; m += NGW) row_pass5(F32 + (size_t)m * DM, P.x + (size_t)m * DM, P.n_post_mix, P.n_pre_ffn, P.out + (size_t)m * DM, XN + (size_t)m * DM, lane); }
    }
    GRID_BAR();
#ifndef REP_P6
#define REP_P6 1
#endif
    for (int rep_ = 0; rep_ < REP_P6; ++rep_) {
    { pg8::Gemm g{XN, Wgu, T_TOK, 2 * FFH, DM, DM}; pg8::StaticOrder S; S.init(T_TOK, 2 * FFH, G, (int)blockIdx.x); EpiSwiglu E{R96};
      pg8::gemm_phase<EpiSwiglu, pg8::StaticOrder, true, true>(lds, g, S, E); }
    }
    GRID_BAR();
#ifndef REP_P7
#define REP_P7 1
#endif
    for (int rep_ = 0; rep_ < REP_P7; ++rep_) {
    { pg8::Gemm g{R96, Wdn, T_TOK, DM, FFH, FFH}; pg8::StaticOrder S; S.init(T_TOK, DM, G, (int)blockIdx.x); EpiF32 E{F32};
      pg8::gemm_phase<EpiF32, pg8::StaticOrder, true, true>(lds, g, S, E); }
    }
    GRID_BAR();
    { PHASE_IDS;
    for (int m = gw; m < T_TOK; m += NGW) row_pass8(F32 + (size_t)m * DM, P.n_post_ffn, P.out + (size_t)m * DM, lane); }
}

extern "C" void kernel_launch(void* const* d_in, const int* in_sizes, int n_in, void* d_out, int out_size, void* d_ws, size_t ws_size, hipStream_t stream) {
    static int grid = 0;
    if (grid == 0) {
        if (n_in != 24 || out_size != T_TOK * DM || ws_size < WS_END) { fprintf(stderr, "kernel_launch: unexpected shapes (n_in %d out %d ws %zu)\n", n_in, out_size, ws_size); grid = -1; return; }
        int dev = 0, cus = 0, per_cu = 0;
        hipGetDevice(&dev); hipDeviceGetAttribute(&cus, hipDeviceAttributeMultiprocessorCount, dev);
        hipFuncSetAttribute((const void*)hybrid_fwd, hipFuncAttributeMaxDynamicSharedMemorySize, LDS_BYTES);
        hipOccupancyMaxActiveBlocksPerMultiprocessor(&per_cu, (const void*)hybrid_fwd, 512, LDS_BYTES);
        if (per_cu < 1) { fprintf(stderr, "kernel_launch: occupancy query says %d blocks/CU\n", per_cu); per_cu = 1; }
        (void)hipGetLastError();
        grid = cus * 1;
    }
    if (grid < 0) return;
    Params p{};
    p.x = (const float*)d_in[0]; p.pos = (const int*)d_in[1]; p.w_in = (const float*)d_in[2]; p.conv_w = (const float*)d_in[3]; p.conv_b = (const float*)d_in[4];
    p.dt_bias = (const float*)d_in[5]; p.a_log = (const float*)d_in[6]; p.d_skip = (const float*)d_in[7]; p.ssm_norm_w = (const float*)d_in[8]; p.w_ssm_out = (const float*)d_in[9];
    p.lq1 = (const float*)d_in[10]; p.lk1 = (const float*)d_in[11]; p.lq2 = (const float*)d_in[12]; p.lk2 = (const float*)d_in[13]; p.subln_w = (const float*)d_in[14];
    p.w_attn_out = (const float*)d_in[15]; p.w_mix = (const float*)d_in[16]; p.n_pre_mix = (const float*)d_in[17]; p.n_post_mix = (const float*)d_in[18];
    p.n_pre_ffn = (const float*)d_in[19]; p.n_post_ffn = (const float*)d_in[20]; p.w_gate = (const float*)d_in[21]; p.w_up = (const float*)d_in[22]; p.w_down = (const float*)d_in[23];
    p.out = (float*)d_out; p.ws = (unsigned char*)d_ws;
    void* args[] = {&p};
    hipError_t e = hipLaunchCooperativeKernel((const void*)hybrid_fwd, dim3(grid), dim3(512), args, LDS_BYTES, stream);
    if (e != hipSuccess) fprintf(stderr, "cooperative launch failed: %s (grid %d)\n", hipGetErrorString(e), grid);
}
```
